# Optimizing an MI355X kernel written in HIP

```python
import jax, jax.numpy as jnp
from jax import lax
import numpy as np

D_MODEL = 1024
BATCH = 32
SEQ = 2048
DEPTH = 4

CHUNK = 64
N_MIXERS = 3
N_LAYERS_A = (DEPTH + 2) // 3
N_LAYERS_B = (DEPTH + 1) // 3
N_LAYERS_C = DEPTH // 3
EPS = 1e-6

D_FF = -(-8 * D_MODEL // (3 * 256)) * 256

SG_BLOCK = 128
SG_WIDTH = 2 * D_MODEL
SG_GROUPS = 8
SG_GROUP_DIM = SG_WIDTH // SG_GROUPS

POOL_WINDOWS = (2, 4, 8, 16)
POOL_WIDTH = D_MODEL
POOL_GROUP_DIM = POOL_WIDTH // len(POOL_WINDOWS)

RET_HEADS = D_MODEL // 256
RET_QK_DIM = D_MODEL // RET_HEADS
RET_V_DIM = 2 * D_MODEL // RET_HEADS
RET_IN_WIDTH = 2 * RET_HEADS * RET_QK_DIM + 2 * RET_HEADS * RET_V_DIM
ROPE_BASE = 10000.0

kernel_name = "hybrid_chunk_causal_gmlp_pool_retention_trunk"


def rmsnorm(x, g):
    xf = x.astype(jnp.float32)
    return xf * lax.rsqrt(jnp.mean(xf * xf, axis=-1, keepdims=True) + EPS) * g.astype(jnp.float32)


def spatial_gating_mixer(h, w_in, v_norm_g, w_s, b_s, w_out):
    B, S, _ = h.shape
    z = jax.nn.gelu(h @ w_in, approximate=False)
    u, v = jnp.split(z, 2, axis=-1)
    vf = v.astype(jnp.float32)
    mu = jnp.mean(vf, axis=-1, keepdims=True)
    var = jnp.mean(jnp.square(vf - mu), axis=-1, keepdims=True)
    v = ((vf - mu) * lax.rsqrt(var + EPS) * v_norm_g.astype(jnp.float32)).astype(h.dtype)
    nb = S // SG_BLOCK
    v = v.reshape(B, nb, SG_BLOCK, SG_GROUPS, SG_GROUP_DIM)
    cpos = jnp.arange(SG_BLOCK) // CHUNK
    mask = cpos[:, None] >= cpos[None, :]
    w = jnp.where(mask[None], w_s, 0)
    mixed = jnp.einsum('gij,bnjgc->bnigc', w, v) + b_s.T[:, :, None]
    gated = u * mixed.reshape(B, S, SG_WIDTH)
    return gated @ w_out


def multiscale_pool_mixer(h, w_in, w_grp, b_grp, scale, w_out):
    B, S, _ = h.shape
    z = h @ w_in
    cs = jnp.cumsum(z.astype(jnp.float32), axis=1)
    t = jnp.arange(S)
    zg = z.reshape(B, S, len(POOL_WINDOWS), POOL_GROUP_DIM).astype(jnp.float32)
    groups = []
    for gi, win in enumerate(POOL_WINDOWS):
        csg = cs[..., gi * POOL_GROUP_DIM:(gi + 1) * POOL_GROUP_DIM]
        prev = jnp.pad(csg, ((0, 0), (win, 0), (0, 0)))[:, :S]
        cnt = jnp.minimum(t + 1, win).astype(jnp.float32)
        groups.append((csg - prev) / cnt[None, :, None] - zg[:, :, gi])
    p = jnp.stack(groups, axis=2).astype(h.dtype)
    y = jnp.einsum('bsgc,gcd->bsgd', p, w_grp) + b_grp
    y = y.reshape(B, S, POOL_WIDTH) * scale
    return y @ w_out


def apply_rope(x, pos):
    d = x.shape[-1]
    inv = ROPE_BASE ** (-jnp.arange(0, d, 2, dtype=jnp.float32) / d)
    ang = pos[:, None] * inv[None, :]
    cos = jnp.cos(ang)[None, :, None, :]
    sin = jnp.sin(ang)[None, :, None, :]
    x1, x2 = x[..., : d // 2], x[..., d // 2:]
    return jnp.concatenate([x1 * cos - x2 * sin, x2 * cos + x1 * sin], axis=-1)


def retention_mixer(h, w_in, w_out):
    B, S, _ = h.shape
    H, dk, dv, C = RET_HEADS, RET_QK_DIM, RET_V_DIM, CHUNK
    N = S // C
    proj = h @ w_in
    qk = H * dk
    q, k, v, g = jnp.split(proj, [qk, 2 * qk, 2 * qk + H * dv], axis=-1)
    pos = jnp.arange(S, dtype=jnp.float32)
    q = apply_rope(q.reshape(B, S, H, dk).astype(jnp.float32), pos)
    k = apply_rope(k.reshape(B, S, H, dk).astype(jnp.float32), pos) * (dk ** -0.5)
    v = v.reshape(B, S, H, dv).astype(jnp.float32)
    qc = q.transpose(0, 2, 1, 3).reshape(B, H, N, C, dk)
    kc = k.transpose(0, 2, 1, 3).reshape(B, H, N, C, dk)
    vc = v.transpose(0, 2, 1, 3).reshape(B, H, N, C, dv)

    log_g = jnp.log(1.0 - jnp.exp2(-5.0 - jnp.arange(H, dtype=jnp.float32)))
    idx = jnp.arange(C, dtype=jnp.float32)
    intra_decay = jnp.exp(log_g[:, None, None] * jnp.abs(idx[:, None] - idx[None, :]))
    q_decay = jnp.exp(log_g[:, None] * (idx + 1.0))[None, :, :, None]
    k_decay = jnp.exp(log_g[:, None] * (C - 1.0 - idx))[None, :, :, None]
    chunk_decay = jnp.exp(log_g * C)[None, :, None, None]

    scores = jnp.einsum('bhncd,bhnmd->bhncm', qc, kc) * intra_decay[None, :, None]
    intra = jnp.einsum('bhncm,bhnme->bhnce', scores, vc)

    def step(state, inp):
        qi, ki, vi = inp
        inter = jnp.einsum('bhcd,bhde->bhce', qi * q_decay, state)
        state = state * chunk_decay + jnp.einsum('bhcd,bhce->bhde', ki * k_decay, vi)
        return state, inter

    xs = (jnp.moveaxis(qc, 2, 0), jnp.moveaxis(kc, 2, 0), jnp.moveaxis(vc, 2, 0))
    _, inter = lax.scan(step, jnp.zeros((B, H, dk, dv), jnp.float32), xs)
    o = (intra + jnp.moveaxis(inter, 0, 2)).reshape(B, H, S, dv)
    o = o * lax.rsqrt(jnp.mean(o * o, axis=-1, keepdims=True) + EPS)
    o = o.transpose(0, 2, 1, 3).reshape(B, S, H * dv).astype(h.dtype)
    return (jax.nn.silu(g) * o) @ w_out


def swiglu(h, w_in, w_out):
    a, b = jnp.split(h @ w_in, 2, axis=-1)
    return (jax.nn.silu(a) * b) @ w_out


def setup_inputs(seed: int = 0) -> dict:
    key = jax.random.key(seed)
    ks = jax.random.split(key, 24)
    f32 = jnp.float32
    D = D_MODEL
    nrm = lambda k, shape, s: jax.random.normal(k, shape, f32) * s
    return {
        "x": nrm(ks[0], (BATCH, SEQ, D), 1.0),
        "c": nrm(ks[1], (BATCH, D), 1.0),
        "norm_mix_g": 1.0 + nrm(ks[2], (DEPTH, D), 0.02),
        "norm_ffn_g": 1.0 + nrm(ks[3], (DEPTH, D), 0.02),
        "w_ada": nrm(ks[4], (DEPTH, D, 6 * D), 0.2 * D ** -0.5),
        "b_ada": nrm(ks[5], (DEPTH, 6 * D), 0.02),
        "w_ffn_in": nrm(ks[6], (DEPTH, D, 2 * D_FF), D ** -0.5),
        "w_ffn_out": nrm(ks[7], (DEPTH, D_FF, D), D_FF ** -0.5),
        "sg_w_in": nrm(ks[8], (N_LAYERS_A, D, 2 * SG_WIDTH), D ** -0.5),
        "sg_v_norm_g": 1.0 + nrm(ks[9], (N_LAYERS_A, SG_WIDTH), 0.02),
        "sg_w_s": nrm(ks[10], (N_LAYERS_A, SG_GROUPS, SG_BLOCK, SG_BLOCK), SG_BLOCK ** -0.5),
        "sg_b_s": 1.0 + nrm(ks[11], (N_LAYERS_A, SG_GROUPS, SG_BLOCK), 0.02),
        "sg_w_out": nrm(ks[12], (N_LAYERS_A, SG_WIDTH, D), SG_WIDTH ** -0.5),
        "pool_w_in": nrm(ks[13], (N_LAYERS_B, D, POOL_WIDTH), D ** -0.5),
        "pool_w_grp": nrm(ks[14], (N_LAYERS_B, len(POOL_WINDOWS), POOL_GROUP_DIM, POOL_GROUP_DIM), POOL_GROUP_DIM ** -0.5),
        "pool_b_grp": nrm(ks[15], (N_LAYERS_B, len(POOL_WINDOWS), POOL_GROUP_DIM), 0.02),
        "pool_scale": 1.0 + nrm(ks[16], (N_LAYERS_B, POOL_WIDTH), 0.02),
        "pool_w_out": nrm(ks[17], (N_LAYERS_B, POOL_WIDTH, D), POOL_WIDTH ** -0.5),
        "ret_w_in": nrm(ks[18], (N_LAYERS_C, D, RET_IN_WIDTH), D ** -0.5),
        "ret_w_out": nrm(ks[19], (N_LAYERS_C, RET_HEADS * RET_V_DIM, D), (RET_HEADS * RET_V_DIM) ** -0.5),
        "final_norm_g": 1.0 + nrm(ks[20], (D,), 0.02),
    }


def reference(x, c, norm_mix_g, norm_ffn_g, w_ada, b_ada, w_ffn_in, w_ffn_out,
              sg_w_in, sg_v_norm_g, sg_w_s, sg_b_s, sg_w_out,
              pool_w_in, pool_w_grp, pool_b_grp, pool_scale, pool_w_out,
              ret_w_in, ret_w_out, final_norm_g):
    dt = x.dtype
    cond = jax.nn.silu(c.astype(jnp.float32))
    for l in range(DEPTH):
        mod = cond @ w_ada[l].astype(jnp.float32) + b_ada[l].astype(jnp.float32)
        sh1, sc1, gt1, sh2, sc2, gt2 = jnp.split(mod[:, None, :], 6, axis=-1)
        h = (rmsnorm(x, norm_mix_g[l]) * (1.0 + sc1) + sh1).astype(dt)
        kind, j = l % N_MIXERS, l // N_MIXERS
        if kind == 0:
            y = spatial_gating_mixer(h, sg_w_in[j], sg_v_norm_g[j], sg_w_s[j], sg_b_s[j], sg_w_out[j])
        elif kind == 1:
            y = multiscale_pool_mixer(h, pool_w_in[j], pool_w_grp[j], pool_b_grp[j], pool_scale[j], pool_w_out[j])
        else:
            y = retention_mixer(h, ret_w_in[j], ret_w_out[j])
        x = (x + (1.0 + gt1) * y).astype(dt)
        h = (rmsnorm(x, norm_ffn_g[l]) * (1.0 + sc2) + sh2).astype(dt)
        x = (x + (1.0 + gt2) * swiglu(h, w_ffn_in[l], w_ffn_out[l])).astype(dt)
    return rmsnorm(x, final_norm_g).astype(dt)
```

```cpp
#include <hip/hip_runtime.h>
#include <hip/hip_cooperative_groups.h>
#include <cstdio>
namespace cg = cooperative_groups;

#define LAS __attribute__((address_space(3)))
typedef unsigned short bf16_t;
typedef short bf16x8 __attribute__((ext_vector_type(8)));
typedef short s16x4 __attribute__((ext_vector_type(4)));
typedef float f32x4 __attribute__((ext_vector_type(4)));
typedef float f32x2 __attribute__((ext_vector_type(2)));
typedef unsigned u32x4 __attribute__((ext_vector_type(4)));
typedef unsigned u32x2 __attribute__((ext_vector_type(2)));
#define DI __device__ __forceinline__

constexpr int D = 1024, BATCH = 32, SEQ = 2048, MTOK = BATCH * SEQ, DEPTH = 4;
constexpr int DFF = 2816, SGW = 2048, RETIN = 6144;
constexpr float EPS = 1e-6f;
constexpr int NTHR = 512;
constexpr int LDS_BYTES = 155648 + 256 + 6144;

constexpr size_t MiB = 1u << 20;
constexpr size_t WS_CBM = 0;
constexpr size_t WS_MOD = 2 * MiB;
constexpr size_t WS_ROPE = 5 * MiB;
constexpr size_t WS_BAR = 7 * MiB;
constexpr size_t WS_W_FFN_IN = 8 * MiB;
constexpr size_t WS_W_FFN_OUT = 52 * MiB;
constexpr size_t WS_W_SG_IN = 74 * MiB;
constexpr size_t WS_W_SG_OUT = 90 * MiB;
constexpr size_t WS_W_POOL_IN = 98 * MiB;
constexpr size_t WS_W_POOL_GRP = 100 * MiB;
constexpr size_t WS_W_POOL_OUT = 101 * MiB;
constexpr size_t WS_W_RET_IN = 103 * MiB;
constexpr size_t WS_W_RET_OUT = 115 * MiB;
constexpr size_t WS_W_SG_S = 119 * MiB;
constexpr size_t WS_H = 120 * MiB;
constexpr size_t WS_T0 = 248 * MiB;
constexpr size_t WS_T1 = 504 * MiB;
constexpr size_t WS_T2 = 760 * MiB;
constexpr size_t WS_SHB = 7 * MiB + 65536;
constexpr size_t WS_GS = 1016 * MiB;
constexpr size_t WS_CBF = 1017 * MiB;
constexpr size_t WS_RSS = 1020 * MiB - 262144;
constexpr size_t WS_END = 1024 * MiB - 262144;

DI unsigned cvt_pk_bf16(float lo, float hi) { unsigned r; asm volatile("v_cvt_pk_bf16_f32 %0, %1, %2" : "=v"(r) : "v"(lo), "v"(hi)); return r; }
DI int otid() { int t = threadIdx.x; asm volatile("" : "+v"(t)); return t; }
DI int obid() { int b = blockIdx.x; asm volatile("" : "+s"(b)); return b; }
DI float bf2f(unsigned short b) { return __uint_as_float(((unsigned)b) << 16); }
DI float bflo(unsigned w) { return __uint_as_float(w << 16); }
DI float bfhi(unsigned w) { return __uint_as_float(w & 0xffff0000u); }
DI float wave_sum(float v) {
#pragma unroll
    for (int o = 1; o < 64; o <<= 1) v += __shfl_xor(v, o);
    return v;
}
DI float silu_f(float x) { return x * __builtin_amdgcn_rcpf(1.0f + __expf(-x)); }
DI f32x2 gelu_pk(f32x2 v) {
    f32x2 t; t.x = __builtin_fminf(__builtin_fmaxf(v.x, -4.0f), 4.0f); t.y = __builtin_fminf(__builtin_fmaxf(v.y, -4.0f), 4.0f);
    const f32x2 u = t * t;
    f32x2 p = u * 8.0634274560e-11f + (-7.0034741092e-09f);
    p = p * u + 2.7161585898e-07f; p = p * u + (-6.2950034497e-06f); p = p * u + 9.8908115557e-05f; p = p * u + (-1.1339223168e-03f);
    p = p * u + 9.8774775034e-03f; p = p * u + (-6.6410595988e-02f); p = p * u + 3.9892270994e-01f;
    const f32x2 phi = p * t + 0.5f;
    return v * phi;
}

#define XB_TMO      128
#define XB_XCNT(j)  (256  + 64 * (j))
#define XB_XSUB(j)  (1280 + 64 * (j))
#define XB_XGEN(j)  (2304 + 64 * (j))
#define XB_TOP      3328
#define XB_TOPGEN   3392
#define XCD_BAR_WORDS 3456
#define XB_SPIN_CAP (1u << 22)
DI unsigned xb_ld(unsigned* p)              { return __hip_atomic_load(p, __ATOMIC_RELAXED, __HIP_MEMORY_SCOPE_AGENT); }
DI unsigned xb_add(unsigned* p, unsigned v) { return __hip_atomic_fetch_add(p, v, __ATOMIC_RELAXED, __HIP_MEMORY_SCOPE_AGENT); }
DI unsigned xb_xcc_id() { return (unsigned)__builtin_amdgcn_s_getreg((3 << 11) | 20) & 0xFu; }
#define XB_SPIN(cond, bar) do { unsigned _sp = 0; while (cond) { __builtin_amdgcn_s_sleep(1); \
    if ((++_sp & 255u) == 0u) { if (xb_ld(&(bar)[XB_TMO])) break; if (_sp > XB_SPIN_CAP) { atomicAdd(&(bar)[XB_TMO], 1u); break; } } } } while (0)
struct XcdBarrier { unsigned* bar; unsigned x; volatile LAS unsigned* st; };
DI XcdBarrier xcd_barrier_post(unsigned* bar, volatile LAS unsigned* st) {
    XcdBarrier b; b.bar = bar; b.x = xb_xcc_id(); b.st = st;
    if (threadIdx.x == 0) (void)xb_add(&bar[XB_XCNT(b.x)], 1u);
    return b;
}
DI void xcd_barrier_complete(unsigned* bar, unsigned x, unsigned& nloc, unsigned& nx) {
    const unsigned G = gridDim.x * gridDim.y * gridDim.z;
    unsigned sum, cnt, mine, sp = 0u;
    for (;;) {
        sum = 0u; cnt = 0u; mine = 0u;
#pragma unroll
        for (unsigned j = 0; j < 16; ++j) { const unsigned c = xb_ld(&bar[XB_XCNT(j)]); sum += c; cnt += (c > 0u) ? 1u : 0u; mine = (j == x) ? c : mine; }
        if (sum == G) break;
        __builtin_amdgcn_s_sleep(1);
        if ((++sp & 255u) == 0u) { if (xb_ld(&bar[XB_TMO])) break; if (sp > XB_SPIN_CAP) { atomicAdd(&bar[XB_TMO], 1u); break; } }
    }
    nloc = mine > 0u ? mine : 1u; nx = cnt > 0u ? cnt : 1u;
}
DI void xcd_barrier(const XcdBarrier& b) {
    asm volatile("s_waitcnt vmcnt(0)" ::: "memory");
    __syncthreads();
    if (threadIdx.x == 0) {
        unsigned* bar = b.bar;
        __builtin_amdgcn_s_waitcnt(0);
        unsigned nloc = b.st[0], nx = b.st[1];
        if (nloc == 0u) { xcd_barrier_complete(bar, b.x, nloc, nx); b.st[0] = nloc; b.st[1] = nx; }
        const unsigned old = xb_add(&bar[XB_XSUB(b.x)], 1u);
        const unsigned gen = old / nloc;
        if (old + 1u == (gen + 1u) * nloc) {
            __builtin_amdgcn_fence(__ATOMIC_RELEASE, "agent");
            asm volatile("s_waitcnt vmcnt(0)" ::: "memory");
            const unsigned og = xb_add(&bar[XB_TOP], 1u);
            const unsigned tg = og / nx;
            if (og + 1u == (tg + 1u) * nx) xb_add(&bar[XB_TOPGEN], 1u);
            else XB_SPIN(xb_ld(&bar[XB_TOPGEN]) == tg, bar);
            __builtin_amdgcn_fence(__ATOMIC_ACQUIRE, "agent");
            xb_add(&bar[XB_XGEN(b.x)], 1u);
            asm volatile("s_waitcnt vmcnt(0)" ::: "memory");
        } else {
            XB_SPIN(xb_ld(&bar[XB_XGEN(b.x)]) == gen, bar);
            __builtin_amdgcn_fence(__ATOMIC_ACQUIRE, "agent");
            asm volatile("s_waitcnt vmcnt(0)" ::: "memory");
        }
    }
    __syncthreads();
}

namespace pg8 {
constexpr int BM = 256, BK = 64, HALF = 128, HTB = HALF * BK * 2, STAGE_BYTES = 8 * HTB, NXCD = 8, WGM = 8;
DI int lds_byte(int r, int c) { const int st = (r >> 4) * 2 + (c >> 5), rr = r & 15, cc = c & 31, ob = rr * 64 + cc * 2; return st * 1024 + (ob ^ (((ob >> 9) & 1) << 5)); }
DI void stage_rc(int b, int& R, int& C) { const int st = b / 1024, sb = b % 1024, swz = sb ^ (((sb >> 9) & 1) << 5); R = (st >> 1) * 16 + swz / 64; C = (st & 1) * 32 + (swz % 64) / 2; }
DI int perm32(int rho) { const int n = rho >> 4, i = rho & 15; return 8 * (i >> 2) + 4 * n + (i & 3); }

struct Unit { int pm, pn; };
struct Gemm { const bf16_t* A; const bf16_t* Bt; int lda, ldb, K, apn; };

struct StaticOrder {
    int nM, nN, nwg, G, c;
    DI void init(int M, int N, int G_, int c_) { nM = M / BM; nN = N / BM; nwg = nM * nN; G = G_; c = c_; }
    DI bool next(int i, Unit& u) const {
        const long L = (long)i * G + c; if (L >= nwg) return false;
        int wgid = (int)L; { const int q = nwg / NXCD, r = nwg % NXCD, xcd = wgid % NXCD, off = wgid / NXCD; wgid = (xcd < r ? xcd * (q + 1) : r * (q + 1) + (xcd - r) * q) + off; }
        const int nig = WGM * nN, gid = wgid / nig, fm = gid * WGM, gsz = (nM - fm) < WGM ? (nM - fm) : WGM;
        u.pm = fm + ((wgid % nig) % gsz); u.pn = (wgid % nig) / gsz; return true;
    }
};

template <class Epi>
DI void gemm_phase(LAS unsigned char* lds, const Gemm g, const StaticOrder& S, const Epi& E) {
    const int tid = otid(), wid = __builtin_amdgcn_readfirstlane(tid >> 6), lane = tid & 63, wr = wid >> 2, wc = wid & 3, fr = lane & 15, fq = lane >> 4;
    const int K = g.K, nt = K / BK;
    unsigned voffA[2], voffB[2];
#pragma unroll
    for (int i = 0; i < 2; ++i) { int R, C; stage_rc(tid * 16 + i * 8192, R, C); const int Rb = Epi::PERM ? ((R & ~31) + perm32(R & 31)) : R;
        voffA[i] = (unsigned)(R * g.lda + C) * 2u; voffB[i] = (unsigned)(Rb * g.ldb + C) * 2u; }
    const size_t kstep = (size_t)(BK * 2);
    const size_t hstepA = (size_t)HALF * g.lda * 2, hstepB = (size_t)HALF * g.ldb * 2;
    const size_t tstepA = 2 * hstepA, tstepB = 2 * hstepB;
    const unsigned ldsw = (unsigned)wid * 1024u;
    const int aoff = lds_byte(wr * 64 + fr, fq * 8), boff = lds_byte(wc * 32 + fr, fq * 8);
#define PG8_SA(b, h) (((b) * 2 + (h)) * HTB)
#define PG8_SB(b, h) ((4 + (b) * 2 + (h)) * HTB)
#define PG8_STAGE(bufoff, gbase, voff) do { _Pragma("unroll") for (int _i = 0; _i < 2; ++_i) \
        __builtin_amdgcn_global_load_lds((const unsigned*)((const char*)(gbase) + (voff)[_i]), (LAS unsigned*)(lds + (bufoff) + ldsw + _i * 8192), 16, 0, 0); } while (0)
#define PG8_LDA(dst, b, h) do { _Pragma("unroll") for (int m = 0; m < 4; ++m) _Pragma("unroll") for (int k = 0; k < 2; ++k) dst[m][k] = *(const LAS bf16x8*)(lds + PG8_SA(b, h) + aoff + m * 2048 + k * 1024); } while (0)
#define PG8_LDB(dst, b, h) do { _Pragma("unroll") for (int n = 0; n < 2; ++n) _Pragma("unroll") for (int k = 0; k < 2; ++k) dst[n][k] = *(const LAS bf16x8*)(lds + PG8_SB(b, h) + boff + n * 2048 + k * 1024); } while (0)
#define PG8_MMA(ai, bj, At, Bt) do { __builtin_amdgcn_s_setprio(1); _Pragma("unroll") for (int m = 0; m < 4; ++m) _Pragma("unroll") for (int n = 0; n < 2; ++n) _Pragma("unroll") for (int k = 0; k < 2; ++k) \
        acc[ai][bj][m][n] = __builtin_amdgcn_mfma_f32_16x16x32_bf16(Bt[n][k], At[m][k], acc[ai][bj][m][n], 0, 0, 0); __builtin_amdgcn_s_setprio(0); } while (0)
#define PG8_WAIT_V(n) asm volatile("s_waitcnt vmcnt(" #n ")" ::: "memory")
#define PG8_WAIT_L(n) asm volatile("s_waitcnt lgkmcnt(" #n ")" ::: "memory")
#define PG8_BAR __builtin_amdgcn_s_barrier()
#define PG8_SCHED __builtin_amdgcn_sched_barrier(0)
    Unit cur, nxt; int ui = 0;
    if (!S.next(0, cur)) return;
    f32x4 acc[2][2][4][2];
#pragma unroll
    for (int a = 0; a < 2; ++a)
#pragma unroll
        for (int b = 0; b < 2; ++b)
#pragma unroll
            for (int m = 0; m < 4; ++m)
#pragma unroll
                for (int n = 0; n < 2; ++n) acc[a][b][m][n] = (f32x4){0.f, 0.f, 0.f, 0.f};
    bf16x8 At[4][2], B0[2][2], B1[2][2];
    const char* cA = (const char*)g.A + (size_t)cur.pm * tstepA + (size_t)cur.pn * g.apn * 2; const char* cB = (const char*)g.Bt + (size_t)cur.pn * tstepB;
    PG8_STAGE(PG8_SB(0, 0), cB, voffB); PG8_STAGE(PG8_SA(0, 0), cA, voffA); PG8_STAGE(PG8_SB(0, 1), cB + hstepB, voffB); PG8_STAGE(PG8_SA(0, 1), cA + hstepA, voffA);
    if (wr == 1) PG8_BAR;
    PG8_WAIT_V(4); PG8_BAR;
    PG8_STAGE(PG8_SB(1, 0), cB + kstep, voffB); PG8_STAGE(PG8_SA(1, 0), cA + kstep, voffA); PG8_STAGE(PG8_SB(1, 1), cB + hstepB + kstep, voffB);
    PG8_WAIT_V(6); PG8_BAR;
    for (;;) {
        const bool has_next = S.next(ui + 1, nxt);
        if (wid == 0) E.stage(cur, ui, lds, lane);
        const char* nA = has_next ? (const char*)g.A + (size_t)nxt.pm * tstepA + (size_t)nxt.pn * g.apn * 2 : cA; const char* nB = has_next ? (const char*)g.Bt + (size_t)nxt.pn * tstepB : cB;
        for (int t = 0; t < nt; t += 2) {
            const bool last = (t == nt - 2);
            const char* a1 = cA + (size_t)(t + 1) * kstep;
            const char* a2 = last ? nA : cA + (size_t)(t + 2) * kstep; const char* b2 = last ? nB : cB + (size_t)(t + 2) * kstep;
            const char* a3 = a2 + kstep; const char* b3 = b2 + kstep;
            PG8_LDB(B0, 0, 0); PG8_SCHED; PG8_LDA(At, 0, 0); PG8_STAGE(PG8_SA(1, 1), a1 + hstepA, voffA);
            PG8_WAIT_L(8); PG8_BAR; PG8_WAIT_L(0); PG8_MMA(0, 0, At, B0); PG8_BAR; PG8_SCHED;
            PG8_LDB(B1, 0, 1); PG8_STAGE(PG8_SB(0, 0), b2, voffB);
            PG8_BAR; PG8_WAIT_L(0); PG8_MMA(0, 1, At, B1); PG8_BAR;
            PG8_LDA(At, 0, 1); PG8_STAGE(PG8_SA(0, 0), a2, voffA);
            PG8_BAR; PG8_WAIT_L(0); PG8_MMA(1, 0, At, B0); PG8_BAR; PG8_SCHED;
            PG8_STAGE(PG8_SB(0, 1), b2 + hstepB, voffB);
            PG8_WAIT_V(6); PG8_BAR; PG8_MMA(1, 1, At, B1); PG8_BAR;
            PG8_LDB(B0, 1, 0); PG8_SCHED; PG8_LDA(At, 1, 0); PG8_STAGE(PG8_SA(0, 1), a2 + hstepA, voffA);
            PG8_WAIT_L(8); PG8_BAR; PG8_WAIT_L(0); PG8_MMA(0, 0, At, B0); PG8_BAR; PG8_SCHED;
            PG8_LDB(B1, 1, 1); PG8_STAGE(PG8_SB(1, 0), b3, voffB);
            PG8_BAR; PG8_WAIT_L(0); PG8_MMA(0, 1, At, B1); PG8_BAR;
            PG8_LDA(At, 1, 1); PG8_STAGE(PG8_SA(1, 0), a3, voffA);
            PG8_BAR; PG8_WAIT_L(0); PG8_MMA(1, 0, At, B0); PG8_BAR; PG8_SCHED;
            PG8_STAGE(PG8_SB(1, 1), b3 + hstepB, voffB);
            PG8_WAIT_V(6); PG8_BAR; PG8_MMA(1, 1, At, B1); PG8_BAR;
        }
        E(acc, cur, ui, wr, wc, fr, fq);
        if (!has_next) break;
#pragma unroll
        for (int a = 0; a < 2; ++a)
#pragma unroll
            for (int b = 0; b < 2; ++b)
#pragma unroll
                for (int m = 0; m < 4; ++m)
#pragma unroll
                    for (int n = 0; n < 2; ++n) acc[a][b][m][n] = (f32x4){0.f, 0.f, 0.f, 0.f};
        cur = nxt; cA = nA; cB = nB; ++ui;
    }
    PG8_WAIT_V(0);
    if (wr == 0) PG8_BAR;
    PG8_BAR;
#undef PG8_SA
#undef PG8_SB
#undef PG8_STAGE
#undef PG8_LDA
#undef PG8_LDB
#undef PG8_MMA
#undef PG8_WAIT_V
#undef PG8_WAIT_L
#undef PG8_BAR
#undef PG8_SCHED
}

typedef f32x4 Acc[2][2][4][2];
constexpr int RSD_OFF = 131072, CV_OFF = 155648 + 256;
DI void stage_vec(LAS unsigned char* lds, const float* g256, int ui, int slot, int lane) { __builtin_amdgcn_global_load_lds((const unsigned*)(g256 + lane * 4), (LAS unsigned*)(lds + CV_OFF + (ui & 1) * 3072 + slot * 1024), 16, 0, 0); }
DI f32x4 read_vec(LAS unsigned char* lds, int ui, int slot, int col) { return *(const LAS f32x4*)(lds + CV_OFF + (ui & 1) * 3072 + slot * 1024 + col * 4); }
DI void prep_rstd(LAS unsigned char* lds, const StaticOrder& S, const float* rss) {
    LAS float* RSD = (LAS float*)(lds + RSD_OFF);
    const int tid = otid();
    for (int ui0 = tid >> 8; ui0 < 24; ui0 += 8) {
        f32x4 p[4][4]; bool ok[4];
#pragma unroll
        for (int k = 0; k < 4; ++k) { Unit u; ok[k] = S.next(ui0 + 2 * k, u);
            const f32x4* pp = (const f32x4*)(rss + (size_t)((ok[k] ? u.pm : 0) * BM + (tid & 255)) * 16);
#pragma unroll
            for (int q = 0; q < 4; ++q) p[k][q] = pp[q]; }
#pragma unroll
        for (int k = 0; k < 4; ++k) { const f32x4 a = p[k][0], b = p[k][1], c = p[k][2], d = p[k][3];
            const float s = (((a[0] + a[1]) + (a[2] + a[3])) + ((b[0] + b[1]) + (b[2] + b[3]))) + (((c[0] + c[1]) + (c[2] + c[3])) + ((d[0] + d[1]) + (d[2] + d[3])));
            if (ok[k]) RSD[(ui0 + 2 * k) * 256 + (tid & 255)] = rsqrtf(s * (1.f / D) + EPS); }
    }
    __syncthreads();
}
struct EpiCB {
    static constexpr bool PERM = true;
    float* C; int ldc;
    DI void stage(const Unit&, int, LAS unsigned char*, int) const {}
    DI void operator()(const Acc& acc, const Unit& u, int ui, int wr, int wc, int fr, int fq) const {
        if (wr != 0) return;
        const int col0 = u.pn * BM + wc * 32 + 8 * fq;
#pragma unroll
        for (int m = 0; m < 2; ++m) { float* rowp = C + (size_t)(m * 16 + fr) * ldc + col0;
#pragma unroll
            for (int bj = 0; bj < 2; ++bj)
#pragma unroll
                for (int n = 0; n < 2; ++n) *(f32x4*)(rowp + bj * HALF + n * 4) = acc[0][bj][m][n]; }
    }
};

struct EpiGeluUV {
    static constexpr bool PERM = true;
    bf16_t* U; bf16_t* V; float* stat; const float* cb; LAS float* rsd; LAS unsigned char* lds;
    DI void stage(const Unit& u, int ui, LAS unsigned char* l, int lane) const { stage_vec(l, cb + (size_t)(u.pm >> 3) * 4096 + u.pn * BM, ui, 0, lane); }
    DI void operator()(const Acc& acc, const Unit& u, int ui, int wr, int wc, int fr, int fq) const {
        const bool isV = u.pn >= 8;
        bf16_t* base = isV ? V : U;
        const int row0 = u.pm * BM + wr * 64 + fr, col0 = (u.pn & 7) * BM + wc * 32 + 8 * fq;
        f32x4 cv[2][2];
#pragma unroll
        for (int bj = 0; bj < 2; ++bj)
#pragma unroll
            for (int n = 0; n < 2; ++n) cv[bj][n] = read_vec(lds, ui, 0, bj * HALF + wc * 32 + 8 * fq + n * 4);
#pragma unroll
        for (int ai = 0; ai < 2; ++ai)
#pragma unroll
            for (int m = 0; m < 4; ++m) {
                const int row = row0 + ai * HALF + m * 16; bf16_t* rowp = base + (size_t)row * SGW + col0; float s = 0.f, q = 0.f;
                const float rs = rsd[ui * 256 + ai * HALF + wr * 64 + m * 16 + fr];
#pragma unroll
                for (int bj = 0; bj < 2; ++bj) {
                    const f32x4 v0 = acc[ai][bj][m][0] * rs + cv[bj][0], v1 = acc[ai][bj][m][1] * rs + cv[bj][1];
                    const f32x2 a = gelu_pk((f32x2){v0[0], v0[1]}), b = gelu_pk((f32x2){v0[2], v0[3]}), c = gelu_pk((f32x2){v1[0], v1[1]}), d = gelu_pk((f32x2){v1[2], v1[3]});
                    u32x4 w; w.x = cvt_pk_bf16(a.x, a.y); w.y = cvt_pk_bf16(b.x, b.y); w.z = cvt_pk_bf16(c.x, c.y); w.w = cvt_pk_bf16(d.x, d.y);
                    *(u32x4*)(rowp + bj * HALF) = w;
                    s += ((a.x + a.y) + (b.x + b.y)) + ((c.x + c.y) + (d.x + d.y));
                    q += ((a.x * a.x + a.y * a.y) + (b.x * b.x + b.y * b.y)) + ((c.x * c.x + c.y * c.y) + (d.x * d.x + d.y * d.y));
                    __builtin_amdgcn_sched_barrier(0);
                }
                if (isV) {
                    s += __shfl_xor(s, 16); s += __shfl_xor(s, 32); q += __shfl_xor(q, 16); q += __shfl_xor(q, 32);
                    if (fq == 0) *(f32x2*)(stat + ((size_t)row * 32 + (u.pn - 8) * 4 + wc) * 2) = (f32x2){s, q};
                }
                asm volatile("" ::: "memory");
            }
    }
};
struct EpiResid {
    static constexpr bool PERM = true;
    bf16_t* XG; const float* gate; const float* gsn; const float* gsc; float* rss; LAS unsigned char* lds;
    DI void stage(const Unit& u, int ui, LAS unsigned char* l, int lane) const {
        stage_vec(l, gate + (size_t)(u.pm >> 3) * 6144 + u.pn * BM, ui, 0, lane);
        if (gsn) stage_vec(l, gsn + (size_t)(u.pm >> 3) * 1024 + u.pn * BM, ui, 1, lane);
        stage_vec(l, gsc + (size_t)(u.pm >> 3) * 1024 + u.pn * BM, ui, 2, lane); }
    DI void operator()(const Acc& acc, const Unit& u, int ui, int wr, int wc, int fr, int fq) const {
        const int row0 = u.pm * BM + wr * 64 + fr, col0 = u.pn * BM + wc * 32 + 8 * fq;
        f32x4 gv[2][2];
#pragma unroll
        for (int bj = 0; bj < 2; ++bj)
#pragma unroll
            for (int n = 0; n < 2; ++n) gv[bj][n] = read_vec(lds, ui, 0, bj * HALF + wc * 32 + 8 * fq + n * 4) + 1.0f;
        float ssq[4];
#pragma unroll
        for (int ai = 0; ai < 2; ++ai) {
            u32x4 xw[4][2];
#pragma unroll
            for (int m = 0; m < 4; ++m)
#pragma unroll
                for (int bj = 0; bj < 2; ++bj) xw[m][bj] = *(const u32x4*)(XG + (size_t)(row0 + ai * HALF + m * 16) * D + col0 + bj * HALF);
#pragma unroll
            for (int bj = 0; bj < 2; ++bj) {
                f32x4 gi[2], gq[2];
#pragma unroll
                for (int n = 0; n < 2; ++n) { const int c = bj * HALF + wc * 32 + 8 * fq + n * 4; const f32x4 g = read_vec(lds, ui, 2, c);
#pragma unroll
                    for (int e = 0; e < 4; ++e) gi[n][e] = __builtin_amdgcn_rcpf(g[e]);
                    gq[n] = gsn ? read_vec(lds, ui, 1, c) : (f32x4){1.f, 1.f, 1.f, 1.f}; }
#pragma unroll
                for (int m = 0; m < 4; ++m) { const size_t off = (size_t)(row0 + ai * HALF + m * 16) * D + col0; const u32x4 xv = xw[m][bj];
                    const f32x4 x0 = (f32x4){bflo(xv.x), bfhi(xv.x), bflo(xv.y), bfhi(xv.y)} * gi[0], x1 = (f32x4){bflo(xv.z), bfhi(xv.z), bflo(xv.w), bfhi(xv.w)} * gi[1];
                    const f32x4 r0 = x0 + gv[bj][0] * acc[ai][bj][m][0], r1 = x1 + gv[bj][1] * acc[ai][bj][m][1];
                    const f32x4 y0 = r0 * gq[0], y1 = r1 * gq[1];
                    u32x4 w; w.x = cvt_pk_bf16(y0[0], y0[1]); w.y = cvt_pk_bf16(y0[2], y0[3]); w.z = cvt_pk_bf16(y1[0], y1[1]); w.w = cvt_pk_bf16(y1[2], y1[3]);
                    *(u32x4*)(XG + off + bj * HALF) = w;
                    const float ssp = ((r0[0] * r0[0] + r0[1] * r0[1]) + (r0[2] * r0[2] + r0[3] * r0[3])) + ((r1[0] * r1[0] + r1[1] * r1[1]) + (r1[2] * r1[2] + r1[3] * r1[3]));
                    if (bj == 0) ssq[m] = ssp; else ssq[m] += ssp; } }
            if (gsn) {
#pragma unroll
                for (int m = 0; m < 4; ++m) { float ss = ssq[m]; ss += __shfl_xor(ss, 16); ss += __shfl_xor(ss, 32); if (fq == 0) rss[(size_t)(row0 + ai * HALF + m * 16) * 16 + u.pn * 4 + wc] = ss; } }
            asm volatile("" ::: "memory"); }
    }
};
struct EpiBf16 {
    static constexpr bool PERM = true;
    bf16_t* O; int ldc; const float* bias; const float* scale; const float* cb; LAS float* rsd; LAS unsigned char* lds;
    DI void stage(const Unit& u, int ui, LAS unsigned char* l, int lane) const { stage_vec(l, cb ? cb + (size_t)(u.pm >> 3) * ldc + u.pn * BM : bias + u.pn * BM, ui, 0, lane); if (scale) stage_vec(l, scale + u.pn * BM, ui, 1, lane); }
    DI void operator()(const Acc& acc, const Unit& u, int ui, int wr, int wc, int fr, int fq) const {
        const int row0 = u.pm * BM + wr * 64 + fr, col0 = u.pn * BM + wc * 32 + 8 * fq;
        f32x4 bv[2][2], sv[2][2];
#pragma unroll
        for (int bj = 0; bj < 2; ++bj)
#pragma unroll
            for (int n = 0; n < 2; ++n) { bv[bj][n] = read_vec(lds, ui, 0, bj * HALF + wc * 32 + 8 * fq + 4 * n);
                sv[bj][n] = scale ? read_vec(lds, ui, 1, bj * HALF + wc * 32 + 8 * fq + 4 * n) : (f32x4){1.f, 1.f, 1.f, 1.f}; }
#pragma unroll
        for (int ai = 0; ai < 2; ++ai)
#pragma unroll
            for (int m = 0; m < 4; ++m) { bf16_t* rowp = O + (size_t)(row0 + ai * HALF + m * 16) * ldc + col0;
                const float rs = cb ? rsd[ui * 256 + ai * HALF + wr * 64 + m * 16 + fr] : 1.0f;
#pragma unroll
                for (int bj = 0; bj < 2; ++bj) { const f32x4 v0 = (acc[ai][bj][m][0] * rs + bv[bj][0]) * sv[bj][0], v1 = (acc[ai][bj][m][1] * rs + bv[bj][1]) * sv[bj][1];
                    u32x4 w; w.x = cvt_pk_bf16(v0[0], v0[1]); w.y = cvt_pk_bf16(v0[2], v0[3]); w.z = cvt_pk_bf16(v1[0], v1[1]); w.w = cvt_pk_bf16(v1[2], v1[3]);
                    *(u32x4*)(rowp + bj * HALF) = w; } }
    }
};
struct EpiRet {
    static constexpr bool PERM = true;
    bf16_t* Q; bf16_t* Kb; bf16_t* V; bf16_t* G; const float* cosT; const float* sinT; const float* cb; LAS float* rsd; LAS unsigned char* lds;
    DI void stage(const Unit& u, int ui, LAS unsigned char* l, int lane) const { stage_vec(l, cb + (size_t)(u.pm >> 3) * RETIN + u.pn * BM, ui, 0, lane); }
    DI void operator()(const Acc& acc, const Unit& u, int ui, int wr, int wc, int fr, int fq) const {
        const int row0 = u.pm * BM + wr * 64 + fr, cw = wc * 32 + 8 * fq;
        f32x4 cv[2][2];
#pragma unroll
        for (int bj = 0; bj < 2; ++bj)
#pragma unroll
            for (int n = 0; n < 2; ++n) cv[bj][n] = read_vec(lds, ui, 0, bj * HALF + cw + n * 4);
        if (u.pn < 8) {
            bf16_t* base = (u.pn < 4 ? Q : Kb) + (u.pn & 3) * 256 + cw; const float sc = u.pn < 4 ? 1.0f : 0.0625f;
#pragma unroll
            for (int ai = 0; ai < 2; ++ai)
#pragma unroll
                for (int m = 0; m < 4; ++m) { const int row = row0 + ai * HALF + m * 16, pos = row & (SEQ - 1);
                    const f32x4 c0 = *(const f32x4*)(cosT + pos * 128 + cw), c1 = *(const f32x4*)(cosT + pos * 128 + cw + 4);
                    const f32x4 s0 = *(const f32x4*)(sinT + pos * 128 + cw), s1 = *(const f32x4*)(sinT + pos * 128 + cw + 4);
                    const float rs = rsd[ui * 256 + ai * HALF + wr * 64 + m * 16 + fr];
                    const f32x4 x10 = acc[ai][0][m][0] * rs + cv[0][0], x11 = acc[ai][0][m][1] * rs + cv[0][1], x20 = acc[ai][1][m][0] * rs + cv[1][0], x21 = acc[ai][1][m][1] * rs + cv[1][1];
                    const f32x4 o10 = (x10 * c0 - x20 * s0) * sc, o11 = (x11 * c1 - x21 * s1) * sc, o20 = (x20 * c0 + x10 * s0) * sc, o21 = (x21 * c1 + x11 * s1) * sc;
                    u32x4 w1, w2; w1.x = cvt_pk_bf16(o10[0], o10[1]); w1.y = cvt_pk_bf16(o10[2], o10[3]); w1.z = cvt_pk_bf16(o11[0], o11[1]); w1.w = cvt_pk_bf16(o11[2], o11[3]);
                    w2.x = cvt_pk_bf16(o20[0], o20[1]); w2.y = cvt_pk_bf16(o20[2], o20[3]); w2.z = cvt_pk_bf16(o21[0], o21[1]); w2.w = cvt_pk_bf16(o21[2], o21[3]);
                    *(u32x4*)(base + (size_t)row * 1024) = w1; *(u32x4*)(base + (size_t)row * 1024 + HALF) = w2; }
        } else {
            const bool isG = u.pn >= 16;
            bf16_t* base = (isG ? G : V) + ((u.pn - 8) & 7) * 256 + cw;
#pragma unroll
            for (int ai = 0; ai < 2; ++ai)
#pragma unroll
                for (int m = 0; m < 4; ++m) { bf16_t* rowp = base + (size_t)(row0 + ai * HALF + m * 16) * 2048;
                    const float rs = rsd[ui * 256 + ai * HALF + wr * 64 + m * 16 + fr];
#pragma unroll
                    for (int bj = 0; bj < 2; ++bj) { f32x4 v0 = acc[ai][bj][m][0] * rs + cv[bj][0], v1 = acc[ai][bj][m][1] * rs + cv[bj][1];
                        if (isG) {
#pragma unroll
                            for (int e = 0; e < 4; ++e) { v0[e] = silu_f(v0[e]); v1[e] = silu_f(v1[e]); } }
                        u32x4 w; w.x = cvt_pk_bf16(v0[0], v0[1]); w.y = cvt_pk_bf16(v0[2], v0[3]); w.z = cvt_pk_bf16(v1[0], v1[1]); w.w = cvt_pk_bf16(v1[2], v1[3]);
                        *(u32x4*)(rowp + bj * HALF) = w; } }
        }
    }
};
struct EpiGate {
    static constexpr bool PERM = true;
    bf16_t* A2; const bf16_t* Ob; const float* nstat; const float* cb; LAS float* rsd; LAS unsigned char* lds;
    DI void stage(const Unit& u, int ui, LAS unsigned char* l, int lane) const { stage_vec(l, cb + (size_t)(u.pm >> 3) * RETIN + 4096 + u.pn * BM, ui, 0, lane); }
    DI void operator()(const Acc& acc, const Unit& u, int ui, int wr, int wc, int fr, int fq) const {
        const int row0 = u.pm * BM + wr * 64 + fr, col0 = u.pn * BM + wc * 32 + 8 * fq, h = u.pn >> 1;
        f32x4 cv[2][2];
#pragma unroll
        for (int bj = 0; bj < 2; ++bj)
#pragma unroll
            for (int n = 0; n < 2; ++n) cv[bj][n] = read_vec(lds, ui, 0, bj * HALF + wc * 32 + 8 * fq + n * 4);
#pragma unroll
        for (int am = 0; am < 4; ++am) { const int ai = am >> 1, mb = (am & 1) * 2;
            u32x4 ow[4][2]; f32x2 ns[4];
#pragma unroll
            for (int m = mb; m < mb + 2; ++m) { const int row = row0 + ai * HALF + m * 16; ns[m] = *(const f32x2*)(nstat + ((size_t)row * 4 + h) * 2);
#pragma unroll
                for (int bj = 0; bj < 2; ++bj) ow[m][bj] = *(const u32x4*)(Ob + (size_t)row * 2048 + col0 + bj * HALF); }
#pragma unroll
            for (int m = mb; m < mb + 2; ++m) { const int row = row0 + ai * HALF + m * 16;
                const float rs = rsd[ui * 256 + ai * HALF + wr * 64 + m * 16 + fr], on = rsqrtf((ns[m].x + ns[m].y) * (1.f / 512.f) + EPS);
#pragma unroll
                for (int bj = 0; bj < 2; ++bj) { const u32x4 ov = ow[m][bj];
                    const f32x4 g0 = acc[ai][bj][m][0] * rs + cv[bj][0], g1 = acc[ai][bj][m][1] * rs + cv[bj][1];
                    const f32x4 o0 = (f32x4){bflo(ov.x), bfhi(ov.x), bflo(ov.y), bfhi(ov.y)} * on, o1 = (f32x4){bflo(ov.z), bfhi(ov.z), bflo(ov.w), bfhi(ov.w)} * on;
                    f32x4 y0, y1;
#pragma unroll
                    for (int e = 0; e < 4; ++e) { y0[e] = silu_f(g0[e]) * o0[e]; y1[e] = silu_f(g1[e]) * o1[e]; }
                    u32x4 w; w.x = cvt_pk_bf16(y0[0], y0[1]); w.y = cvt_pk_bf16(y0[2], y0[3]); w.z = cvt_pk_bf16(y1[0], y1[1]); w.w = cvt_pk_bf16(y1[2], y1[3]);
                    *(u32x4*)(A2 + (size_t)row * 2048 + col0 + bj * HALF) = w; } }
            asm volatile("" ::: "memory"); }
    }
};
struct EpiSwiglu {
    static constexpr bool PERM = true;
    bf16_t* O; const float* cb; LAS float* rsd; LAS unsigned char* lds;
    DI void stage(const Unit& u, int ui, LAS unsigned char* l, int lane) const { stage_vec(l, cb + (size_t)(u.pm >> 3) * (2 * DFF) + u.pn * BM, ui, 0, lane); }
    DI void operator()(const Acc& acc, const Unit& u, int ui, int wr, int wc, int fr, int fq) const {
        const int row0 = u.pm * BM + wr * 64 + fr, col0 = u.pn * HALF + wc * 32 + 8 * fq;
        f32x4 cv[2][2];
#pragma unroll
        for (int bj = 0; bj < 2; ++bj)
#pragma unroll
            for (int n = 0; n < 2; ++n) cv[bj][n] = read_vec(lds, ui, 0, bj * HALF + wc * 32 + 8 * fq + n * 4);
        float rsv[2][4];
#pragma unroll
        for (int ai = 0; ai < 2; ++ai)
#pragma unroll
            for (int m = 0; m < 4; ++m) rsv[ai][m] = rsd[ui * 256 + ai * HALF + wr * 64 + m * 16 + fr];
#pragma unroll
        for (int ai = 0; ai < 2; ++ai)
#pragma unroll
            for (int m = 0; m < 4; ++m) { bf16_t* rowp = O + (size_t)(row0 + ai * HALF + m * 16) * DFF + col0;
                const float rs = rsv[ai][m];
                unsigned wv[4];
#pragma unroll
                for (int n = 0; n < 2; ++n)
#pragma unroll
                    for (int hh = 0; hh < 2; ++hh) {
                        const f32x2 ar = {acc[ai][0][m][n][2 * hh], acc[ai][0][m][n][2 * hh + 1]}, br = {acc[ai][1][m][n][2 * hh], acc[ai][1][m][n][2 * hh + 1]};
                        const f32x2 ca = {cv[0][n][2 * hh], cv[0][n][2 * hh + 1]}, cb2 = {cv[1][n][2 * hh], cv[1][n][2 * hh + 1]};
                        const f32x2 a2 = ar * rs + ca, b2 = br * rs + cb2;
                        const f32x2 t = a2 * (-1.44269504089f);
                        f32x2 e; e.x = __builtin_amdgcn_exp2f(t.x); e.y = __builtin_amdgcn_exp2f(t.y);
                        const f32x2 d = e + 1.0f;
                        f32x2 r; r.x = __builtin_amdgcn_rcpf(d.x); r.y = __builtin_amdgcn_rcpf(d.y);
                        const f32x2 o = (a2 * r) * b2;
                        wv[2 * n + hh] = cvt_pk_bf16(o.x, o.y); }
                u32x4 w; w.x = wv[0]; w.y = wv[1]; w.z = wv[2]; w.w = wv[3];
                *(u32x4*)rowp = w; }
    }
};
}

struct Args {
    const float* in[21];
    float* out;
    unsigned char* ws;
    int ph_lo, ph_hi;
};

DI void transpose_item(const float* W, int K, int N, bf16_t* WT, int kb, int ns0, int nd0, LAS float* scr, int lane) {
    const int k0 = 64 * kb;
    float wv[32];
#pragma unroll
    for (int i = 0; i < 32; ++i) wv[i] = W[(size_t)(k0 + 2 * i + (lane >> 5)) * N + ns0 + (lane & 31)];
#pragma unroll
    for (int i = 0; i < 32; ++i) scr[(2 * i + (lane >> 5)) * 33 + (lane & 31)] = wv[i];
    asm volatile("s_waitcnt lgkmcnt(0)" ::: "memory");
    const int c = lane & 7;
#pragma unroll
    for (int j = 0; j < 4; ++j) { const int n = (lane >> 3) + 8 * j; const LAS float* s = scr + (8 * c) * 33 + n;
        u32x4 o; o.x = cvt_pk_bf16(s[0 * 33], s[1 * 33]); o.y = cvt_pk_bf16(s[2 * 33], s[3 * 33]); o.z = cvt_pk_bf16(s[4 * 33], s[5 * 33]); o.w = cvt_pk_bf16(s[6 * 33], s[7 * 33]);
        *(u32x4*)(WT + (size_t)(nd0 + n) * K + k0 + 8 * c) = o; }
    asm volatile("s_waitcnt lgkmcnt(0)" ::: "memory");
}
DI bool transpose_set(int& r, const float* W, int K, int N, int nmat, bf16_t* WT, LAS float* scr, int lane) {
    const int per = (K / 64) * (N / 32), tot = per * nmat;
    if (r >= tot) { r -= tot; return false; }
    const int mi = r / per, it = r % per, nblk = N / 32, kb = it / nblk, nb = it % nblk;
    transpose_item(W + (size_t)mi * K * N, K, N, WT + (size_t)mi * K * N, kb, 32 * nb, 32 * nb, scr, lane);
    return true;
}

DI void phase_prep(const Args& a, LAS unsigned char* lds) {
    const int tid = otid(), lane = tid & 63, wave = tid >> 6, G = gridDim.x, bid = obid();
    unsigned char* ws = a.ws;
    if (bid < 192) {
        LAS float* sc = (LAS float*)lds;
        LAS float* red = (LAS float*)(lds + 131072);
        const float* c = a.in[1];
        for (int i0 = tid; i0 < 32 * 1024; i0 += 16 * NTHR) { float cv_[16];
#pragma unroll
            for (int u = 0; u < 16; ++u) cv_[u] = c[i0 + u * NTHR];
#pragma unroll
            for (int u = 0; u < 16; ++u) { const int i = i0 + u * NTHR, b = i >> 10, k = i & 1023; sc[k * 32 + b] = silu_f(cv_[u]); } }
        for (int i = tid; i < 32 * 128; i += NTHR) red[i] = 0.f;
        __syncthreads();
        const int l = bid / 48, n0 = (bid % 48) * 128, col = tid & 127, kq = tid >> 7;
        const float* W = a.in[4] + (size_t)l * D * 6144 + n0 + col;
        float acc[32];
#pragma unroll
        for (int b = 0; b < 32; ++b) acc[b] = 0.f;
        for (int k0 = kq * 256; k0 < kq * 256 + 256; k0 += 32) {
            float wv[32];
#pragma unroll
            for (int u = 0; u < 32; ++u) wv[u] = W[(size_t)(k0 + u) * 6144];
#pragma unroll
            for (int u = 0; u < 32; ++u) {
                const float w = wv[u];
                const LAS f32x4* s4 = (const LAS f32x4*)(sc + (k0 + u) * 32);
#pragma unroll
                for (int j = 0; j < 8; ++j) { const f32x4 s = s4[j]; acc[4 * j] += w * s[0]; acc[4 * j + 1] += w * s[1]; acc[4 * j + 2] += w * s[2]; acc[4 * j + 3] += w * s[3]; }
            }
        }
        for (int r = 0; r < 4; ++r) {
            if (kq == r) {
#pragma unroll
                for (int b = 0; b < 32; ++b) red[b * 128 + col] = (r == 0 ? 0.f : red[b * 128 + col]) + acc[b]; }
            __syncthreads(); }
        float* mod = (float*)(ws + WS_MOD) + (size_t)l * 32 * 6144 + n0;
        const float* bias = a.in[5] + (size_t)l * 6144 + n0;
        const int seg = n0 >> 10;
        bf16_t* shb = (bf16_t*)(ws + WS_SHB) + (size_t)(32 * (2 * l + (seg == 3))) * 1024 + (n0 & 1023);
        float* gs = (float*)(ws + WS_GS) + (size_t)(2 * l + (seg == 4)) * 32 * 1024 + (n0 & 1023);
        const float* ng = a.in[seg == 1 ? 2 : 3] + l * D + (n0 & 1023);
        for (int i = tid; i < 32 * 128; i += NTHR) { const int b = i >> 7, n = i & 127; const float v = red[i] + bias[n]; mod[(size_t)b * 6144 + n] = v;
            if (seg == 0 || seg == 3) shb[(size_t)b * 1024 + n] = (bf16_t)(cvt_pk_bf16(v, 0.f) & 0xffffu);
            if (seg == 1 || seg == 4) gs[(size_t)b * 1024 + n] = ng[n] * (1.0f + v); }
        __syncthreads();
    }
    if (bid == 255) { unsigned* bw = (unsigned*)(ws + WS_BAR); for (int i = tid; i < 4096; i += NTHR) bw[i] = 0u; }
    {
        const size_t gt = (size_t)bid * NTHR + tid, GT = (size_t)G * NTHR;
        float* cosT = (float*)(ws + WS_ROPE); float* sinT = cosT + SEQ * 128;
        for (size_t i = gt; i < (size_t)SEQ * 128; i += GT) { const int pos = (int)(i >> 7), fi = (int)(i & 127);
            const float inv = exp2f(-(float)fi * (13.287712379549449f / 128.0f)); const float ang = (float)pos * inv;
            const double rev = (double)ang * 0.15915494309189535; const float fr = (float)(rev - rint(rev));
            cosT[i] = __builtin_amdgcn_cosf(fr); sinT[i] = __builtin_amdgcn_sinf(fr); }
        bf16_t* wsg = (bf16_t*)(ws + WS_W_SG_S); const float* w_s = a.in[10];
        for (size_t i = gt; i < (size_t)2 * 8 * 128 * 128; i += GT) { const int ii = (int)((i >> 7) & 127), jj = (int)(i & 127);
            const float v = ((ii >> 6) >= (jj >> 6)) ? w_s[i] : 0.f; wsg[i] = (bf16_t)(cvt_pk_bf16(v, 0.f) & 0xffffu); }
    }
    {
        LAS float* scr = (LAS float*)(lds + wave * 16384);
        const int gw = bid * 8 + wave, NGW = G * 8;
        constexpr int I_FI = (D / 64) * (2 * DFF / 32) * 4, I_FO = (DFF / 64) * (D / 32) * 4, I_SI = (D / 64) * (4096 / 32) * 2, I_SO = (SGW / 64) * (D / 32) * 2,
                      I_PI = (D / 64) * (D / 32), I_PG = (256 / 64) * (256 / 32) * 4, I_PO = I_PI, I_RI = (D / 64) * (RETIN / 32), I_RO = (2048 / 64) * (D / 32);
        constexpr int NITEMS = I_FI + I_FO + I_SI + I_SO + I_PI + I_PG + I_PO + I_RI + I_RO;
        for (int it = gw; it < NITEMS; it += NGW) {
            int r = it;
            if (r < I_FI) {
                const int per = (D / 64) * (2 * DFF / 32), l = r / per, q = r % per, nblk = 2 * DFF / 32, kb = q / nblk, nb = q % nblk, rd = 32 * nb;
                const int ns0 = ((rd & 255) >> 7) * DFF + 128 * (rd >> 8) + (rd & 127);
                transpose_item(a.in[6] + (size_t)l * D * 2 * DFF, D, 2 * DFF, (bf16_t*)(ws + WS_W_FFN_IN) + (size_t)l * D * 2 * DFF, kb, ns0, rd, scr, lane);
                continue; }
            r -= I_FI;
            if (transpose_set(r, a.in[7], DFF, D, 4, (bf16_t*)(ws + WS_W_FFN_OUT), scr, lane)) continue;
            if (transpose_set(r, a.in[8], D, 4096, 2, (bf16_t*)(ws + WS_W_SG_IN), scr, lane)) continue;
            if (transpose_set(r, a.in[12], SGW, D, 2, (bf16_t*)(ws + WS_W_SG_OUT), scr, lane)) continue;
            if (transpose_set(r, a.in[13], D, D, 1, (bf16_t*)(ws + WS_W_POOL_IN), scr, lane)) continue;
            if (transpose_set(r, a.in[14], 256, 256, 4, (bf16_t*)(ws + WS_W_POOL_GRP), scr, lane)) continue;
            if (transpose_set(r, a.in[17], D, D, 1, (bf16_t*)(ws + WS_W_POOL_OUT), scr, lane)) continue;
            if (transpose_set(r, a.in[18], D, RETIN, 1, (bf16_t*)(ws + WS_W_RET_IN), scr, lane)) continue;
            transpose_set(r, a.in[19], 2048, D, 1, (bf16_t*)(ws + WS_W_RET_OUT), scr, lane);
        }
    }
}

DI void phase_xg0(const float* x, const float* gs, bf16_t* XG, float* rss) {
    const int tid_ = otid(), lane = tid_ & 63, gw = obid() * 8 + (tid_ >> 6), NGW = gridDim.x * 8;
    for (int row0 = gw * 4; row0 < MTOK; row0 += NGW * 4) {
        const int b = row0 >> 11;
        f32x4 v[4][4];
#pragma unroll
        for (int r = 0; r < 4; ++r)
#pragma unroll
            for (int j = 0; j < 4; ++j) v[r][j] = *((const f32x4*)(x + (size_t)(row0 + r) * D) + lane + 64 * j);
#pragma unroll
        for (int r = 0; r < 4; ++r) { float s = 0.f;
#pragma unroll
            for (int j = 0; j < 4; ++j) s += (v[r][j].x * v[r][j].x + v[r][j].y * v[r][j].y) + (v[r][j].z * v[r][j].z + v[r][j].w * v[r][j].w);
            s = wave_sum(s);
            if (lane < 16) rss[(size_t)(row0 + r) * 16 + lane] = lane == 0 ? s : 0.f; }
#pragma unroll
        for (int j = 0; j < 4; ++j) { const int col = 4 * lane + 256 * j;
            const f32x4 g4 = *(const f32x4*)(gs + (size_t)b * 1024 + col);
#pragma unroll
            for (int r = 0; r < 4; ++r) { const f32x4 h = v[r][j] * g4;
                u32x2 w; w.x = cvt_pk_bf16(h[0], h[1]); w.y = cvt_pk_bf16(h[2], h[3]); *((u32x2*)(XG + (size_t)(row0 + r) * D) + lane + 64 * j) = w; } }
    }
}
DI void phase_final_norm(const bf16_t* xb, const float* g, float* out) {
    const int tid_ = otid(), lane = tid_ & 63, gw = obid() * 8 + (tid_ >> 6), NGW = gridDim.x * 8;
    for (int row0 = gw * 4; row0 < MTOK; row0 += NGW * 4) {
        u32x4 w[4][2]; float rstd[4];
#pragma unroll
        for (int r = 0; r < 4; ++r)
#pragma unroll
            for (int j = 0; j < 2; ++j) w[r][j] = *((const u32x4*)(xb + (size_t)(row0 + r) * D) + lane + 64 * j);
#pragma unroll
        for (int r = 0; r < 4; ++r) { float s = 0.f;
#pragma unroll
            for (int j = 0; j < 2; ++j) { const u32x4 v = w[r][j];
                s += ((bflo(v.x) * bflo(v.x) + bfhi(v.x) * bfhi(v.x)) + (bflo(v.y) * bflo(v.y) + bfhi(v.y) * bfhi(v.y))) + ((bflo(v.z) * bflo(v.z) + bfhi(v.z) * bfhi(v.z)) + (bflo(v.w) * bflo(v.w) + bfhi(v.w) * bfhi(v.w))); }
            rstd[r] = rsqrtf(wave_sum(s) * (1.f / D) + EPS); }
#pragma unroll
        for (int j = 0; j < 2; ++j) { const int col = 8 * lane + 512 * j;
            const f32x4 g0 = *(const f32x4*)(g + col), g1 = *(const f32x4*)(g + col + 4);
#pragma unroll
            for (int r = 0; r < 4; ++r) { const u32x4 v = w[r][j]; float* o = out + (size_t)(row0 + r) * D + col;
                *(f32x4*)o = (f32x4){bflo(v.x), bfhi(v.x), bflo(v.y), bfhi(v.y)} * rstd[r] * g0;
                *(f32x4*)(o + 4) = (f32x4){bflo(v.z), bfhi(v.z), bflo(v.w), bfhi(v.w)} * rstd[r] * g1; } }
    }
}

DI void phase_sg(LAS unsigned char* lds, const bf16_t* U, const bf16_t* V, const float* stat, const float* gam, const bf16_t* Wm, const float* bs, bf16_t* O) {
    constexpr int WST = 272, VST = 272;
    LAS unsigned char* WI = lds; LAS unsigned char* VT = lds + 128 * WST; LAS f32x2* ST = (LAS f32x2*)(VT + 256 * VST);
    const int tid = otid(), bid = obid(), lane = tid & 63, wid = tid >> 6, wr = wid >> 2, wc = wid & 3, fr = lane & 15, fq = lane >> 4;
    const int g = bid & 7, G = gridDim.x;
    for (int p = tid; p < 128 * 16; p += NTHR) { const int i = p >> 4, jc = p & 15; *(LAS u32x4*)(WI + i * WST + jc * 16) = *(const u32x4*)(Wm + (size_t)g * 16384 + i * 128 + jc * 8); }
    u32x4 vw[2][4]; f32x4 sp[4]; f32x2 stn = (f32x2){0.f, 0.f};
    const f32x4 gm0 = *(const f32x4*)(gam + 256 * g + 8 * (tid & 31)), gm1 = *(const f32x4*)(gam + 256 * g + 8 * (tid & 31) + 4);
#define SG_LOADV(item) do { const int tk0_ = ((item) >> 3) * 128; _Pragma("unroll") for (int q = 0; q < 2; ++q) { const int task = tid + q * NTHR, cgp = task & 31, jg = task >> 5; \
        _Pragma("unroll") for (int r = 0; r < 4; ++r) vw[q][r] = *(const u32x4*)(V + (size_t)(tk0_ + 4 * jg + r) * SGW + 256 * g + 8 * cgp); } } while (0)
#define SG_LOADS(item) do { const f32x4* pp_ = (const f32x4*)(stat + (size_t)(((item) >> 3) * 128 + (tid >> 2)) * 64) + (tid & 3) * 4; _Pragma("unroll") for (int k = 0; k < 4; ++k) sp[k] = pp_[k]; } while (0)
#define SG_REDS() do { float s_ = ((sp[0][0] + sp[0][2]) + (sp[1][0] + sp[1][2])) + ((sp[2][0] + sp[2][2]) + (sp[3][0] + sp[3][2])), q_ = ((sp[0][1] + sp[0][3]) + (sp[1][1] + sp[1][3])) + ((sp[2][1] + sp[2][3]) + (sp[3][1] + sp[3][3])); \
        s_ += __shfl_xor(s_, 1); q_ += __shfl_xor(q_, 1); s_ += __shfl_xor(s_, 2); q_ += __shfl_xor(q_, 2); \
        const float mu_ = s_ * (1.f / SGW), var_ = q_ * (1.f / SGW) - mu_ * mu_; stn = (f32x2){mu_, rsqrtf(fmaxf(var_, 0.f) + EPS)}; } while (0)
    if (bid < 4096) { SG_LOADV(bid); SG_LOADS(bid); SG_REDS(); }
    for (int it = bid; it < 4096; it += G) {
        const int nb = it >> 3; const int tok0 = nb * 128; const bool more = it + G < 4096;
        if ((tid & 3) == 0) ST[tid >> 2] = stn;
        __syncthreads();
#pragma unroll
        for (int q = 0; q < 2; ++q) {
            const int task = tid + q * NTHR, cgp = task & 31, jg = task >> 5;
            const f32x4 g0 = gm0, g1 = gm1;
            float vals[4][8];
#pragma unroll
            for (int r = 0; r < 4; ++r) { const u32x4 w = vw[q][r];
                const f32x2 st = ST[4 * jg + r]; const float mu = st.x, rstd = st.y;
                vals[r][0] = (bflo(w.x) - mu) * rstd * g0[0]; vals[r][1] = (bfhi(w.x) - mu) * rstd * g0[1]; vals[r][2] = (bflo(w.y) - mu) * rstd * g0[2]; vals[r][3] = (bfhi(w.y) - mu) * rstd * g0[3];
                vals[r][4] = (bflo(w.z) - mu) * rstd * g1[0]; vals[r][5] = (bfhi(w.z) - mu) * rstd * g1[1]; vals[r][6] = (bflo(w.w) - mu) * rstd * g1[2]; vals[r][7] = (bfhi(w.w) - mu) * rstd * g1[3]; }
#pragma unroll
            for (int cc = 0; cc < 8; ++cc) { u32x2 w; w.x = cvt_pk_bf16(vals[0][cc], vals[1][cc]); w.y = cvt_pk_bf16(vals[2][cc], vals[3][cc]);
                *(LAS u32x2*)(VT + (8 * cgp + cc) * VST + 8 * jg) = w; }
        }
        __syncthreads();
        u32x4 uw[4][2];
#pragma unroll
        for (int t = 0; t < 4; ++t)
#pragma unroll
            for (int p2 = 0; p2 < 2; ++p2) uw[t][p2] = *(const u32x4*)(U + (size_t)(tok0 + 64 * wr + 16 * t + fr) * SGW + 256 * g + 64 * wc + 32 * p2 + 8 * fq);
        if (more) { SG_LOADV(it + G); SG_LOADS(it + G); }
        f32x4 acc[2][2][4];
#pragma unroll
        for (int p2 = 0; p2 < 2; ++p2)
#pragma unroll
            for (int q = 0; q < 2; ++q)
#pragma unroll
                for (int t = 0; t < 4; ++t) acc[p2][q][t] = (f32x4){0.f, 0.f, 0.f, 0.f};
        const int nks = wr ? 4 : 2;
        for (int ks = 0; ks < nks; ++ks) {
            bf16x8 bw[4], av[2][2];
#pragma unroll
            for (int t = 0; t < 4; ++t) bw[t] = *(const LAS bf16x8*)(WI + (64 * wr + 16 * t + fr) * WST + (32 * ks + 8 * fq) * 2);
#pragma unroll
            for (int p2 = 0; p2 < 2; ++p2)
#pragma unroll
                for (int q = 0; q < 2; ++q) av[p2][q] = *(const LAS bf16x8*)(VT + (32 * (2 * wc + p2) + 8 * (fr >> 2) + 4 * q + (fr & 3)) * VST + (32 * ks + 8 * fq) * 2);
#pragma unroll
            for (int p2 = 0; p2 < 2; ++p2)
#pragma unroll
                for (int q = 0; q < 2; ++q)
#pragma unroll
                    for (int t = 0; t < 4; ++t) acc[p2][q][t] = __builtin_amdgcn_mfma_f32_16x16x32_bf16(av[p2][q], bw[t], acc[p2][q][t], 0, 0, 0);
        }
#pragma unroll
        for (int t = 0; t < 4; ++t) { const int i = 64 * wr + 16 * t + fr; const float bias = bs[g * 128 + i];
#pragma unroll
            for (int p2 = 0; p2 < 2; ++p2) { const size_t off = (size_t)(tok0 + i) * SGW + 256 * g + 64 * wc + 32 * p2 + 8 * fq;
                const u32x4 u4 = uw[t][p2]; const f32x4 a0 = acc[p2][0][t] + bias, a1 = acc[p2][1][t] + bias;
                u32x4 w; w.x = cvt_pk_bf16(bflo(u4.x) * a0[0], bfhi(u4.x) * a0[1]); w.y = cvt_pk_bf16(bflo(u4.y) * a0[2], bfhi(u4.y) * a0[3]);
                w.z = cvt_pk_bf16(bflo(u4.z) * a1[0], bfhi(u4.z) * a1[1]); w.w = cvt_pk_bf16(bflo(u4.w) * a1[2], bfhi(u4.w) * a1[3]);
                *(u32x4*)(O + off) = w; } }
        if (more) SG_REDS();
    }
#undef SG_LOADV
#undef SG_LOADS
#undef SG_REDS
}

DI void phase_pool(const bf16_t* Z, bf16_t* P) {
    const int gtid = obid() * NTHR + otid(), GT = gridDim.x * NTHR;
    for (int task = gtid; task < (MTOK / 64) * 128; task += GT) {
        const int cg8 = task & 127, run = task >> 7, ch = 8 * cg8, win = 2 << (ch >> 8);
        const int tok0 = run * 64, t0 = tok0 & (SEQ - 1);
        float s[8];
#pragma unroll
        for (int e = 0; e < 8; ++e) s[e] = 0.f;
        for (int d = 1; d < win; ++d) { if (t0 - d >= 0) { const u32x4 w = *(const u32x4*)(Z + (size_t)(tok0 - d) * D + ch);
            s[0] += bflo(w.x); s[1] += bfhi(w.x); s[2] += bflo(w.y); s[3] += bfhi(w.y); s[4] += bflo(w.z); s[5] += bfhi(w.z); s[6] += bflo(w.w); s[7] += bfhi(w.w); } }
        for (int i0 = 0; i0 < 64; i0 += 8) {
            u32x4 wn[8], wo[8];
#pragma unroll
            for (int u = 0; u < 8; ++u) { wn[u] = *(const u32x4*)(Z + (size_t)(tok0 + i0 + u) * D + ch);
                const int tl = t0 + i0 + u - win + 1; wo[u] = tl >= 0 ? *(const u32x4*)(Z + (size_t)(tok0 + i0 + u - win + 1) * D + ch) : (u32x4){0u, 0u, 0u, 0u}; }
#pragma unroll
            for (int u = 0; u < 8; ++u) { const int t = t0 + i0 + u; const u32x4 w = wn[u];
                float z[8] = {bflo(w.x), bfhi(w.x), bflo(w.y), bfhi(w.y), bflo(w.z), bfhi(w.z), bflo(w.w), bfhi(w.w)};
#pragma unroll
                for (int e = 0; e < 8; ++e) s[e] += z[e];
                const float rc = 1.0f / (float)(t + 1 < win ? t + 1 : win);
                u32x4 o; o.x = cvt_pk_bf16(s[0] * rc - z[0], s[1] * rc - z[1]); o.y = cvt_pk_bf16(s[2] * rc - z[2], s[3] * rc - z[3]);
                o.z = cvt_pk_bf16(s[4] * rc - z[4], s[5] * rc - z[5]); o.w = cvt_pk_bf16(s[6] * rc - z[6], s[7] * rc - z[7]);
                *(u32x4*)(P + (size_t)(tok0 + i0 + u) * D + ch) = o;
                const u32x4 x = wo[u];
                s[0] -= bflo(x.x); s[1] -= bfhi(x.x); s[2] -= bflo(x.y); s[3] -= bfhi(x.y); s[4] -= bflo(x.z); s[5] -= bfhi(x.z); s[6] -= bflo(x.w); s[7] -= bfhi(x.w); }
        }
    }
}

DI void phase_ret(LAS unsigned char* lds, const bf16_t* Qb, const bf16_t* Kb, bf16_t* VO, float* nstat) {
    constexpr int QST = 528, TST = 144;
    LAS unsigned char* QI = lds; LAS unsigned char* KI = lds + 64 * QST; LAS unsigned char* KT = KI + 64 * QST; LAS unsigned char* VT = KT + 256 * TST;
    LAS unsigned char* PI = VT + 256 * TST; LAS float* RS = (LAS float*)(PI + 64 * TST);
    const int tid = otid(), lane = tid & 63, w = tid >> 6, fr = lane & 15, fq = lane >> 4;
    const int cg4 = tid >> 5, dg = tid & 31;
    for (int it = obid(); it < 256; it += gridDim.x) {
        const int b = it >> 3, h = (it >> 1) & 3, sl = it & 1;
        const float l2g_ = log2f(1.0f - exp2f(-5.0f - (float)h));
        f32x4 St[16][2];
#pragma unroll
        for (int t = 0; t < 16; ++t) { St[t][0] = (f32x4){0.f, 0.f, 0.f, 0.f}; St[t][1] = (f32x4){0.f, 0.f, 0.f, 0.f}; }
        const bf16_t* kp = Kb + (size_t)(b * SEQ + 4 * cg4) * 1024 + 256 * h + 8 * dg;
        const bf16_t* vp = VO + (size_t)(b * SEQ + 4 * cg4) * 2048 + 512 * h + 256 * sl + 8 * dg;
        const bf16_t* qp = Qb + (size_t)(b * SEQ + (tid >> 5)) * 1024 + 256 * h + 8 * dg;
        for (int n = 0; n < 32; ++n) {
            const int t0 = b * SEQ + n * 64;
            float l2g = l2g_; asm volatile("" : "+v"(l2g));
            const float cd = exp2f(l2g * 64.0f);
            {
              u32x4 vw[4], kw[4];
#pragma unroll
              for (int r = 0; r < 4; ++r) kw[r] = *(const u32x4*)(kp + (size_t)(n * 64 + r) * 1024);
#pragma unroll
              for (int r = 0; r < 4; ++r) *(LAS u32x4*)(KI + (4 * cg4 + r) * QST + 16 * dg) = kw[r];
#pragma unroll
              for (int r = 0; r < 4; ++r) vw[r] = *(const u32x4*)(vp + (size_t)(n * 64 + r) * 2048);
              { u32x4 qw[4];
#pragma unroll
              for (int r = 0; r < 4; ++r) qw[r] = *(const u32x4*)(qp + (size_t)(n * 64 + 16 * r) * 1024);
#pragma unroll
              for (int r = 0; r < 4; ++r) *(LAS u32x4*)(QI + ((tid >> 5) + 16 * r) * QST + 16 * dg) = qw[r]; }
              float kd[4];
#pragma unroll
              for (int r = 0; r < 4; ++r) kd[r] = exp2f(l2g * (float)(63 - (4 * cg4 + r)));
#pragma unroll
              for (int dd = 0; dd < 8; ++dd) { float v[4];
#pragma unroll
                  for (int r = 0; r < 4; ++r) { const unsigned wd = dd < 2 ? kw[r].x : dd < 4 ? kw[r].y : dd < 6 ? kw[r].z : kw[r].w; v[r] = ((dd & 1) ? bfhi(wd) : bflo(wd)) * kd[r]; }
                  u32x2 o; o.x = cvt_pk_bf16(v[0], v[1]); o.y = cvt_pk_bf16(v[2], v[3]);
                  *(LAS u32x2*)(KT + (8 * dg + dd) * TST + 8 * cg4) = o; }
#pragma unroll
              for (int ee = 0; ee < 8; ++ee) { unsigned v[4];
#pragma unroll
                  for (int r = 0; r < 4; ++r) { const unsigned wd = ee < 2 ? vw[r].x : ee < 4 ? vw[r].y : ee < 6 ? vw[r].z : vw[r].w; v[r] = (ee & 1) ? (wd >> 16) : (wd & 0xffffu); }
                  u32x2 o; o.x = v[0] | (v[1] << 16); o.y = v[2] | (v[3] << 16);
                  *(LAS u32x2*)(VT + (8 * dg + ee) * TST + 8 * cg4) = o; }
            }
            __syncthreads();
            { const int mt = w >> 1;
              f32x4 s0 = (f32x4){0.f, 0.f, 0.f, 0.f}, s1 = s0;
#pragma unroll
              for (int ks = 0; ks < 8; ++ks) {
                  const bf16x8 ka = *(const LAS bf16x8*)(KI + (16 * mt + fr) * QST + (32 * ks + 8 * fq) * 2);
                  const bf16x8 q0 = *(const LAS bf16x8*)(QI + (16 * (2 * (w & 1)) + fr) * QST + (32 * ks + 8 * fq) * 2);
                  const bf16x8 q1 = *(const LAS bf16x8*)(QI + (16 * (2 * (w & 1) + 1) + fr) * QST + (32 * ks + 8 * fq) * 2);
                  s0 = __builtin_amdgcn_mfma_f32_16x16x32_bf16(ka, q0, s0, 0, 0, 0);
                  s1 = __builtin_amdgcn_mfma_f32_16x16x32_bf16(ka, q1, s1, 0, 0, 0); }
#pragma unroll
              for (int z = 0; z < 2; ++z) { const int c = 16 * (2 * (w & 1) + z) + fr; const f32x4 sv = z ? s1 : s0; float p[4];
#pragma unroll
                  for (int j = 0; j < 4; ++j) { const int m = 16 * mt + 4 * fq + j; const int dist = c > m ? c - m : m - c; p[j] = sv[j] * exp2f(l2g * (float)dist); }
                  u32x2 o; o.x = cvt_pk_bf16(p[0], p[1]); o.y = cvt_pk_bf16(p[2], p[3]);
                  *(LAS u32x2*)(PI + c * TST + (16 * mt + 4 * fq) * 2) = o; } }
            __syncthreads();
            f32x4 O[2][4];
#pragma unroll
            for (int nt = 0; nt < 2; ++nt)
#pragma unroll
                for (int mt = 0; mt < 4; ++mt) O[nt][mt] = (f32x4){0.f, 0.f, 0.f, 0.f};
#pragma unroll
            for (int ks = 0; ks < 8; ++ks) {
                bf16x8 sa[2];
#pragma unroll
                for (int nt = 0; nt < 2; ++nt) { u32x4 pb; pb.x = cvt_pk_bf16(St[2 * ks][nt][0], St[2 * ks][nt][1]); pb.y = cvt_pk_bf16(St[2 * ks][nt][2], St[2 * ks][nt][3]);
                    pb.z = cvt_pk_bf16(St[2 * ks + 1][nt][0], St[2 * ks + 1][nt][1]); pb.w = cvt_pk_bf16(St[2 * ks + 1][nt][2], St[2 * ks + 1][nt][3]); sa[nt] = __builtin_bit_cast(bf16x8, pb); }
#pragma unroll
                for (int mt = 0; mt < 4; ++mt) {
                    const u32x2 lo = *(const LAS u32x2*)(QI + (16 * mt + fr) * QST + (32 * ks + 4 * fq) * 2);
                    const u32x2 hi = *(const LAS u32x2*)(QI + (16 * mt + fr) * QST + (32 * ks + 16 + 4 * fq) * 2);
                    u32x4 pq; pq.x = lo.x; pq.y = lo.y; pq.z = hi.x; pq.w = hi.y; const bf16x8 qf = __builtin_bit_cast(bf16x8, pq);
                    O[0][mt] = __builtin_amdgcn_mfma_f32_16x16x32_bf16(sa[0], qf, O[0][mt], 0, 0, 0);
                    O[1][mt] = __builtin_amdgcn_mfma_f32_16x16x32_bf16(sa[1], qf, O[1][mt], 0, 0, 0); }
            }
#pragma unroll
            for (int mt = 0; mt < 4; ++mt) { const float qd = exp2f(l2g * (float)(16 * mt + fr + 1)); O[0][mt] *= qd; O[1][mt] *= qd; }
            bf16x8 vb[2][2];
#pragma unroll
            for (int nt = 0; nt < 2; ++nt)
#pragma unroll
                for (int ks = 0; ks < 2; ++ks) vb[nt][ks] = *(const LAS bf16x8*)(VT + (32 * w + 16 * nt + fr) * TST + (32 * ks + 8 * fq) * 2);
#pragma unroll
            for (int ks = 0; ks < 2; ++ks)
#pragma unroll
                for (int mt = 0; mt < 4; ++mt) {
                    const bf16x8 pa = *(const LAS bf16x8*)(PI + (16 * mt + fr) * TST + (32 * ks + 8 * fq) * 2);
                    O[0][mt] = __builtin_amdgcn_mfma_f32_16x16x32_bf16(vb[0][ks], pa, O[0][mt], 0, 0, 0);
                    O[1][mt] = __builtin_amdgcn_mfma_f32_16x16x32_bf16(vb[1][ks], pa, O[1][mt], 0, 0, 0); }
#pragma unroll
            for (int mt = 0; mt < 4; ++mt) { float q = 0.f;
#pragma unroll
                for (int nt = 0; nt < 2; ++nt) { const f32x4 v = O[nt][mt];
                    u32x2 o; o.x = cvt_pk_bf16(v[0], v[1]); o.y = cvt_pk_bf16(v[2], v[3]);
                    *(u32x2*)(VO + (size_t)(t0 + 16 * mt + fr) * 2048 + 512 * h + 256 * sl + 32 * w + 16 * nt + 4 * fq) = o;
                    q += (v[0] * v[0] + v[1] * v[1]) + (v[2] * v[2] + v[3] * v[3]); }
                q += __shfl_xor(q, 16); q += __shfl_xor(q, 32);
                if (fq == 0) RS[(16 * mt + fr) * 8 + w] = q; }
#pragma unroll
            for (int t = 0; t < 16; ++t) { St[t][0] *= cd; St[t][1] *= cd;
#pragma unroll
                for (int ks = 0; ks < 2; ++ks) { const bf16x8 ka = *(const LAS bf16x8*)(KT + (16 * t + fr) * TST + (32 * ks + 8 * fq) * 2);
                    St[t][0] = __builtin_amdgcn_mfma_f32_16x16x32_bf16(ka, vb[0][ks], St[t][0], 0, 0, 0);
                    St[t][1] = __builtin_amdgcn_mfma_f32_16x16x32_bf16(ka, vb[1][ks], St[t][1], 0, 0, 0); } }
            __syncthreads();
            if (tid < 64) { float q = 0.f;
#pragma unroll
                for (int k = 0; k < 8; ++k) q += RS[tid * 8 + k];
                nstat[((size_t)(t0 + tid) * 4 + h) * 2 + sl] = q; }
        }
    }
}
DI void phase_gate(bf16_t* Gb, const bf16_t* Ob, const float* nstat) {
    const size_t gt = (size_t)obid() * NTHR + otid(), GT = (size_t)gridDim.x * NTHR;
    for (size_t i0 = gt; i0 < (size_t)MTOK * 256; i0 += 4 * GT) {
        u32x4 gw[4], ow[4]; f32x2 ns[4];
#pragma unroll
        for (int u = 0; u < 4; ++u) { const size_t i = i0 + u * GT; const size_t tok = i >> 8; const int c8 = (int)(i & 255) * 8, h = c8 >> 9;
            gw[u] = *(const u32x4*)(Gb + tok * 2048 + c8); ow[u] = *(const u32x4*)(Ob + tok * 2048 + c8); ns[u] = *(const f32x2*)(nstat + (tok * 4 + h) * 2); }
#pragma unroll
        for (int u = 0; u < 4; ++u) { const size_t i = i0 + u * GT; const size_t tok = i >> 8; const int c8 = (int)(i & 255) * 8;
            const float rstd = rsqrtf((ns[u].x + ns[u].y) * (1.f / 512.f) + EPS);
            u32x4 r; r.x = cvt_pk_bf16(bflo(gw[u].x) * bflo(ow[u].x) * rstd, bfhi(gw[u].x) * bfhi(ow[u].x) * rstd); r.y = cvt_pk_bf16(bflo(gw[u].y) * bflo(ow[u].y) * rstd, bfhi(gw[u].y) * bfhi(ow[u].y) * rstd);
            r.z = cvt_pk_bf16(bflo(gw[u].z) * bflo(ow[u].z) * rstd, bfhi(gw[u].z) * bfhi(ow[u].z) * rstd); r.w = cvt_pk_bf16(bflo(gw[u].w) * bflo(ow[u].w) * rstd, bfhi(gw[u].w) * bfhi(ow[u].w) * rstd);
            *(u32x4*)(Gb + tok * 2048 + c8) = r; }
    }
}

__global__ void __launch_bounds__(NTHR, 2) fwd_megakernel(Args a) {
    extern __shared__ __attribute__((aligned(16))) unsigned char lds_raw[];
    LAS unsigned char* lds = (LAS unsigned char*)lds_raw;
    cg::grid_group grid = cg::this_grid();
    volatile LAS unsigned* MISC = (volatile LAS unsigned*)(lds + 155648);
    if (threadIdx.x < 64) MISC[threadIdx.x] = 0u;
    __syncthreads();
    XcdBarrier xbar; xbar.bar = (unsigned*)(a.ws + WS_BAR); xbar.x = 0; xbar.st = MISC;
    for (int ph = a.ph_lo; ph < a.ph_hi; ++ph) {
        unsigned char* ws = a.ws;
        const int G = gridDim.x;
        float* mod = (float*)(ws + WS_MOD);
        bf16_t* H = (bf16_t*)(ws + WS_H);
        bf16_t* T0 = (bf16_t*)(ws + WS_T0); bf16_t* T1 = (bf16_t*)(ws + WS_T1); bf16_t* T2 = (bf16_t*)(ws + WS_T2);
        float* xo = a.out;
        float* rss = (float*)(ws + WS_RSS);
        const float* gsb = (const float*)(ws + WS_GS);
        LAS float* rsd = (LAS float*)(lds + pg8::RSD_OFF);
        pg8::StaticOrder S;
        if (ph == 0) { phase_prep(a, lds); }
        else if (ph == 1) {
            const int c = obid();
            if (c < 148) {
                int l, which = 0, N, loc; const bf16_t* Bt; float* cbo;
                if (c < 16) { l = 0; loc = c; N = 4096; Bt = (const bf16_t*)(ws + WS_W_SG_IN); cbo = (float*)(ws + WS_CBM); }
                else if (c < 20) { l = 1; loc = c - 16; N = 1024; Bt = (const bf16_t*)(ws + WS_W_POOL_IN); cbo = (float*)(ws + WS_CBM) + 131072; }
                else if (c < 44) { l = 2; loc = c - 20; N = RETIN; Bt = (const bf16_t*)(ws + WS_W_RET_IN); cbo = (float*)(ws + WS_CBM) + 163840; }
                else if (c < 60) { l = 3; loc = c - 44; N = 4096; Bt = (const bf16_t*)(ws + WS_W_SG_IN) + (size_t)4096 * D; cbo = (float*)(ws + WS_CBM) + 360448; }
                else { l = (c - 60) / 22; loc = (c - 60) % 22; N = 2 * DFF; which = 1; Bt = (const bf16_t*)(ws + WS_W_FFN_IN) + (size_t)l * 2 * DFF * D; cbo = (float*)(ws + WS_CBF) + (size_t)l * 32 * 2 * DFF; }
                pg8::Gemm g{(const bf16_t*)(ws + WS_SHB) + (size_t)(32 * (2 * l + which)) * 1024, Bt, D, D, D, 0};
                S.init(256, N, N / 256, loc); pg8::EpiCB E{cbo, N}; pg8::gemm_phase(lds, g, S, E);
            }
            phase_xg0(a.in[0], gsb, H, rss);
        }
        else if (ph == 24) { phase_final_norm(H, a.in[20], xo); }
        else {
            const int l = ph >= 19 ? 3 : ph >= 13 ? 2 : ph >= 7 ? 1 : 0;
            const int base = l == 3 ? 19 : l == 2 ? 13 : l == 1 ? 7 : 2;
            const int kind = l % 3, j = l / 3, nmix = kind == 0 ? 2 : 3;
            const int s = ph - base;
            const float* modl = mod + (size_t)l * 32 * 6144;
            if (s < nmix) {
                if (kind == 0) {
                    float* stat = (float*)T2;
                    if (s == 0) { pg8::Gemm g{H, (const bf16_t*)(ws + WS_W_SG_IN) + (size_t)j * 4096 * D, D, D, D, 0}; S.init(MTOK, 4096, G, obid()); pg8::prep_rstd(lds, S, rss);
                        pg8::EpiGeluUV E{T0, T1, stat, (const float*)(ws + WS_CBM) + (l == 0 ? 0 : 360448), rsd, lds}; pg8::gemm_phase(lds, g, S, E); }
                    else { phase_sg(lds, T0, T1, stat, a.in[9] + j * SGW, (const bf16_t*)(ws + WS_W_SG_S) + (size_t)j * 8 * 16384, a.in[11] + j * 8 * 128, T0); }
                } else if (kind == 1) {
                    if (s == 0) { pg8::Gemm g{H, (const bf16_t*)(ws + WS_W_POOL_IN), D, D, D, 0}; S.init(MTOK, D, G, obid()); pg8::prep_rstd(lds, S, rss);
                        pg8::EpiBf16 E{T0, D, nullptr, nullptr, (const float*)(ws + WS_CBM) + 131072, rsd, lds}; pg8::gemm_phase(lds, g, S, E); }
                    else if (s == 1) { phase_pool(T0, T1); }
                    else { pg8::Gemm g{T1, (const bf16_t*)(ws + WS_W_POOL_GRP), D, 256, 256, 256}; S.init(MTOK, D, G, obid());
                        pg8::EpiBf16 E{T2, D, a.in[15], a.in[16], nullptr, rsd, lds}; pg8::gemm_phase(lds, g, S, E); }
                } else {
                    bf16_t* Qb = T0; bf16_t* Kb = T0 + (size_t)MTOK * 1024; float* nstat = xo;
                    if (s == 0) { pg8::Gemm g{H, (const bf16_t*)(ws + WS_W_RET_IN), D, D, D, 0}; S.init(MTOK, 4096, G, obid()); pg8::prep_rstd(lds, S, rss);
                        pg8::EpiRet E{Qb, Kb, T1, T2, (const float*)(ws + WS_ROPE), (const float*)(ws + WS_ROPE) + SEQ * 128, (const float*)(ws + WS_CBM) + 163840, rsd, lds}; pg8::gemm_phase(lds, g, S, E); }
                    else if (s == 1) { phase_ret(lds, Qb, Kb, T1, nstat); }
                    else { pg8::Gemm g{H, (const bf16_t*)(ws + WS_W_RET_IN) + (size_t)4096 * D, D, D, D, 0}; S.init(MTOK, 2048, G, obid()); pg8::prep_rstd(lds, S, rss);
                        pg8::EpiGate E{T2, T1, nstat, (const float*)(ws + WS_CBM) + 163840, rsd, lds}; pg8::gemm_phase(lds, g, S, E); }
                }
            }
            else if (s == nmix || s == nmix + 2) {
                pg8::Gemm g2; const float* gate; const float* gsn; const float* gsc;
                if (s == nmix + 2) { g2 = pg8::Gemm{T0, (const bf16_t*)(ws + WS_W_FFN_OUT) + (size_t)l * D * DFF, DFF, DFF, DFF, 0}; gate = modl + 5120; gsc = gsb + (size_t)(2 * l + 1) * 32 * 1024; gsn = l < 3 ? gsb + (size_t)(2 * l + 2) * 32 * 1024 : nullptr; }
                else { gate = modl + 2048; gsc = gsb + (size_t)(2 * l) * 32 * 1024; gsn = gsb + (size_t)(2 * l + 1) * 32 * 1024;
                    if (kind == 0) g2 = pg8::Gemm{T0, (const bf16_t*)(ws + WS_W_SG_OUT) + (size_t)j * D * SGW, SGW, SGW, SGW, 0};
                    else if (kind == 1) g2 = pg8::Gemm{T2, (const bf16_t*)(ws + WS_W_POOL_OUT), D, D, D, 0};
                    else g2 = pg8::Gemm{T2, (const bf16_t*)(ws + WS_W_RET_OUT), 2048, 2048, 2048, 0}; }
                S.init(MTOK, D, G, obid()); pg8::EpiResid E{H, gate, gsn, gsc, rss, lds}; pg8::gemm_phase(lds, g2, S, E);
            }
            else { pg8::Gemm g{H, (const bf16_t*)(ws + WS_W_FFN_IN) + (size_t)l * 2 * DFF * D, D, D, D, 0}; S.init(MTOK, 2 * DFF, G, obid()); pg8::prep_rstd(lds, S, rss);
                pg8::EpiSwiglu E{T0, (const float*)(ws + WS_CBF) + (size_t)l * 32 * 2 * DFF, rsd, lds}; pg8::gemm_phase(lds, g, S, E); }
        }
        if (ph + 1 < a.ph_hi) {
            if (ph == a.ph_lo) { grid.sync(); xbar = xcd_barrier_post((unsigned*)(a.ws + WS_BAR), MISC); }
            else xcd_barrier(xbar);
        }
    }
}

#ifndef MK_PER_PHASE
#define MK_PER_PHASE 0
#endif
constexpr int N_PHASES = 2 + (5 + 6 + 6 + 5) + 1;

extern "C" void kernel_launch(void* const* d_in, const int* in_sizes, int n_in, void* d_out, int out_size, void* d_ws, size_t ws_size, hipStream_t stream) {
    static int grid = 0;
    if (grid == 0) {
        if (n_in != 21 || ws_size < WS_END) { fprintf(stderr, "kernel_launch: unexpected n_in %d / ws_size %zu\n", n_in, ws_size); grid = -1; return; }
        int dev = 0, cus = 0, per_cu = 0;
        hipGetDevice(&dev);
        hipDeviceGetAttribute(&cus, hipDeviceAttributeMultiprocessorCount, dev);
        if (hipFuncSetAttribute((const void*)fwd_megakernel, hipFuncAttributeMaxDynamicSharedMemorySize, LDS_BYTES) != hipSuccess) { fprintf(stderr, "kernel_launch: hipFuncSetAttribute failed\n"); grid = -1; return; }
        if (hipOccupancyMaxActiveBlocksPerMultiprocessor(&per_cu, (const void*)fwd_megakernel, NTHR, LDS_BYTES) != hipSuccess || per_cu < 1) { fprintf(stderr, "kernel_launch: occupancy query says %d\n", per_cu); per_cu = 1; }
        (void)hipGetLastError();
        grid = cus;
        if (grid != 256) fprintf(stderr, "kernel_launch: %d CUs\n", grid);
    }
    if (grid < 0) return;
    Args a{};
    for (int i = 0; i < 21; ++i) a.in[i] = (const float*)d_in[i];
    a.out = (float*)d_out; a.ws = (unsigned char*)d_ws;
#if MK_PER_PHASE
    for (int p = 0; p < N_PHASES; ++p) { a.ph_lo = p; a.ph_hi = p + 1; hipLaunchKernelGGL(fwd_megakernel, dim3(grid), dim3(NTHR), LDS_BYTES, stream, a); }
#else
    a.ph_lo = 0; a.ph_hi = N_PHASES;
    void* args[] = {&a};
    hipError_t e = hipLaunchCooperativeKernel((const void*)fwd_megakernel, dim3(grid), dim3(NTHR), args, LDS_BYTES, stream);
    if (e != hipSuccess) fprintf(stderr, "kernel_launch: cooperative launch failed: %s\n", hipGetErrorString(e));
#endif
}
```

```cpp
#include <hip/hip_runtime.h>
#include <hip/hip_cooperative_groups.h>
#include <cstdio>
namespace cg = cooperative_groups;

#define LAS __attribute__((address_space(3)))
typedef unsigned short bf16_t;
typedef short bf16x8 __attribute__((ext_vector_type(8)));
typedef short s16x4 __attribute__((ext_vector_type(4)));
typedef float f32x4 __attribute__((ext_vector_type(4)));
typedef float f32x2 __attribute__((ext_vector_type(2)));
typedef unsigned u32x4 __attribute__((ext_vector_type(4)));
typedef unsigned u32x2 __attribute__((ext_vector_type(2)));
#define DI __device__ __forceinline__

constexpr int D = 1024, BATCH = 32, SEQ = 2048, MTOK = BATCH * SEQ, DEPTH = 4;
constexpr int DFF = 2816, SGW = 2048, RETIN = 6144;
constexpr float EPS = 1e-6f;
constexpr int NTHR = 512;
constexpr int LDS_BYTES = 155648 + 256 + 6144;

constexpr size_t MiB = 1u << 20;
constexpr size_t WS_CBM = 0;
constexpr size_t WS_MOD = 2 * MiB;
constexpr size_t WS_ROPE = 5 * MiB;
constexpr size_t WS_BAR = 7 * MiB;
constexpr size_t WS_W_FFN_IN = 8 * MiB;
constexpr size_t WS_W_FFN_OUT = 52 * MiB;
constexpr size_t WS_W_SG_IN = 74 * MiB;
constexpr size_t WS_W_SG_OUT = 90 * MiB;
constexpr size_t WS_W_POOL_IN = 98 * MiB;
constexpr size_t WS_W_POOL_GRP = 100 * MiB;
constexpr size_t WS_W_POOL_OUT = 101 * MiB;
constexpr size_t WS_W_RET_IN = 103 * MiB;
constexpr size_t WS_W_RET_OUT = 115 * MiB;
constexpr size_t WS_W_SG_S = 119 * MiB;
constexpr size_t WS_H = 120 * MiB;
constexpr size_t WS_T0 = 248 * MiB;
constexpr size_t WS_T1 = 504 * MiB;
constexpr size_t WS_T2 = 760 * MiB;
constexpr size_t WS_SHB = 7 * MiB + 65536;
constexpr size_t WS_GS = 1016 * MiB;
constexpr size_t WS_CBF = 1017 * MiB;
constexpr size_t WS_RSS = 1020 * MiB - 262144;
constexpr size_t WS_END = 1024 * MiB - 262144;

DI unsigned cvt_pk_bf16(float lo, float hi) { unsigned r; asm volatile("v_cvt_pk_bf16_f32 %0, %1, %2" : "=v"(r) : "v"(lo), "v"(hi)); return r; }
DI int otid() { int t = threadIdx.x; asm volatile("" : "+v"(t)); return t; }
DI int obid() { int b = blockIdx.x; asm volatile("" : "+s"(b)); return b; }
DI float bf2f(unsigned short b) { return __uint_as_float(((unsigned)b) << 16); }
DI float bflo(unsigned w) { return __uint_as_float(w << 16); }
DI float bfhi(unsigned w) { return __uint_as_float(w & 0xffff0000u); }
DI float wave_sum(float v) {
#pragma unroll
    for (int o = 1; o < 64; o <<= 1) v += __shfl_xor(v, o);
    return v;
}
DI float silu_f(float x) { return x * __builtin_amdgcn_rcpf(1.0f + __expf(-x)); }
DI f32x2 gelu_pk(f32x2 v) {
    f32x2 t; t.x = __builtin_fminf(__builtin_fmaxf(v.x, -4.0f), 4.0f); t.y = __builtin_fminf(__builtin_fmaxf(v.y, -4.0f), 4.0f);
    const f32x2 u = t * t;
    f32x2 p = u * 8.0634274560e-11f + (-7.0034741092e-09f);
    p = p * u + 2.7161585898e-07f; p = p * u + (-6.2950034497e-06f); p = p * u + 9.8908115557e-05f; p = p * u + (-1.1339223168e-03f);
    p = p * u + 9.8774775034e-03f; p = p * u + (-6.6410595988e-02f); p = p * u + 3.9892270994e-01f;
    const f32x2 phi = p * t + 0.5f;
    return v * phi;
}

#define XB_TMO      128
#define XB_XCNT(j)  (256  + 64 * (j))
#define XB_XSUB(j)  (1280 + 64 * (j))
#define XB_XGEN(j)  (2304 + 64 * (j))
#define XB_TOP      3328
#define XB_TOPGEN   3392
#define XCD_BAR_WORDS 3456
#define XB_SPIN_CAP (1u << 22)
DI unsigned xb_ld(unsigned* p)              { return __hip_atomic_load(p, __ATOMIC_RELAXED, __HIP_MEMORY_SCOPE_AGENT); }
DI unsigned xb_add(unsigned* p, unsigned v) { return __hip_atomic_fetch_add(p, v, __ATOMIC_RELAXED, __HIP_MEMORY_SCOPE_AGENT); }
DI unsigned xb_xcc_id() { return (unsigned)__builtin_amdgcn_s_getreg((3 << 11) | 20) & 0xFu; }
#define XB_SPIN(cond, bar) do { unsigned _sp = 0; while (cond) { __builtin_amdgcn_s_sleep(1); \
    if ((++_sp & 255u) == 0u) { if (xb_ld(&(bar)[XB_TMO])) break; if (_sp > XB_SPIN_CAP) { atomicAdd(&(bar)[XB_TMO], 1u); break; } } } } while (0)
struct XcdBarrier { unsigned* bar; unsigned x; volatile LAS unsigned* st; };
DI XcdBarrier xcd_barrier_post(unsigned* bar, volatile LAS unsigned* st) {
    XcdBarrier b; b.bar = bar; b.x = xb_xcc_id(); b.st = st;
    if (threadIdx.x == 0) (void)xb_add(&bar[XB_XCNT(b.x)], 1u);
    return b;
}
DI void xcd_barrier_complete(unsigned* bar, unsigned x, unsigned& nloc, unsigned& nx) {
    const unsigned G = gridDim.x * gridDim.y * gridDim.z;
    unsigned sum, cnt, mine, sp = 0u;
    for (;;) {
        sum = 0u; cnt = 0u; mine = 0u;
#pragma unroll
        for (unsigned j = 0; j < 16; ++j) { const unsigned c = xb_ld(&bar[XB_XCNT(j)]); sum += c; cnt += (c > 0u) ? 1u : 0u; mine = (j == x) ? c : mine; }
        if (sum == G) break;
        __builtin_amdgcn_s_sleep(1);
        if ((++sp & 255u) == 0u) { if (xb_ld(&bar[XB_TMO])) break; if (sp > XB_SPIN_CAP) { atomicAdd(&bar[XB_TMO], 1u); break; } }
    }
    nloc = mine > 0u ? mine : 1u; nx = cnt > 0u ? cnt : 1u;
}
DI void xcd_barrier(const XcdBarrier& b) {
    asm volatile("s_waitcnt vmcnt(0)" ::: "memory");
    __syncthreads();
    if (threadIdx.x == 0) {
        unsigned* bar = b.bar;
        __builtin_amdgcn_s_waitcnt(0);
        unsigned nloc = b.st[0], nx = b.st[1];
        if (nloc == 0u) { xcd_barrier_complete(bar, b.x, nloc, nx); b.st[0] = nloc; b.st[1] = nx; }
        const unsigned old = xb_add(&bar[XB_XSUB(b.x)], 1u);
        const unsigned gen = old / nloc;
        if (old + 1u == (gen + 1u) * nloc) {
            __builtin_amdgcn_fence(__ATOMIC_RELEASE, "agent");
            asm volatile("s_waitcnt vmcnt(0)" ::: "memory");
            const unsigned og = xb_add(&bar[XB_TOP], 1u);
            const unsigned tg = og / nx;
            if (og + 1u == (tg + 1u) * nx) xb_add(&bar[XB_TOPGEN], 1u);
            else XB_SPIN(xb_ld(&bar[XB_TOPGEN]) == tg, bar);
            __builtin_amdgcn_fence(__ATOMIC_ACQUIRE, "agent");
            xb_add(&bar[XB_XGEN(b.x)], 1u);
            asm volatile("s_waitcnt vmcnt(0)" ::: "memory");
        } else {
            XB_SPIN(xb_ld(&bar[XB_XGEN(b.x)]) == gen, bar);
            __builtin_amdgcn_fence(__ATOMIC_ACQUIRE, "agent");
            asm volatile("s_waitcnt vmcnt(0)" ::: "memory");
        }
    }
    __syncthreads();
}

namespace pg8 {
constexpr int BM = 256, BK = 64, HALF = 128, HTB = HALF * BK * 2, STAGE_BYTES = 8 * HTB, NXCD = 8, WGM = 8;
DI int lds_byte(int r, int c) { const int st = (r >> 4) * 2 + (c >> 5), rr = r & 15, cc = c & 31, ob = rr * 64 + cc * 2; return st * 1024 + (ob ^ (((ob >> 9) & 1) << 5)); }
DI void stage_rc(int b, int& R, int& C) { const int st = b / 1024, sb = b % 1024, swz = sb ^ (((sb >> 9) & 1) << 5); R = (st >> 1) * 16 + swz / 64; C = (st & 1) * 32 + (swz % 64) / 2; }
DI int perm32(int rho) { const int n = rho >> 4, i = rho & 15; return 8 * (i >> 2) + 4 * n + (i & 3); }

struct Unit { int pm, pn; };
struct Gemm { const bf16_t* A; const bf16_t* Bt; int lda, ldb, K, apn; };

struct StaticOrder {
    int nM, nN, nwg, G, c;
    DI void init(int M, int N, int G_, int c_) { nM = M / BM; nN = N / BM; nwg = nM * nN; G = G_; c = c_; }
    DI bool next(int i, Unit& u) const {
        const long L = (long)i * G + c; if (L >= nwg) return false;
        int wgid = (int)L; { const int q = nwg / NXCD, r = nwg % NXCD, xcd = wgid % NXCD, off = wgid / NXCD; wgid = (xcd < r ? xcd * (q + 1) : r * (q + 1) + (xcd - r) * q) + off; }
        const int nig = WGM * nN, gid = wgid / nig, fm = gid * WGM, gsz = (nM - fm) < WGM ? (nM - fm) : WGM;
        u.pm = fm + ((wgid % nig) % gsz); u.pn = (wgid % nig) / gsz; return true;
    }
};

template <class Epi>
DI void gemm_phase(LAS unsigned char* lds, const Gemm g, const StaticOrder& S, const Epi& E) {
    const int tid = otid(), wid = __builtin_amdgcn_readfirstlane(tid >> 6), lane = tid & 63, wr = wid >> 2, wc = wid & 3, fr = lane & 15, fq = lane >> 4;
    const int K = g.K, nt = K / BK;
    unsigned voffA[2], voffB[2];
#pragma unroll
    for (int i = 0; i < 2; ++i) { int R, C; stage_rc(tid * 16 + i * 8192, R, C); const int Rb = Epi::PERM ? ((R & ~31) + perm32(R & 31)) : R;
        voffA[i] = (unsigned)(R * g.lda + C) * 2u; voffB[i] = (unsigned)(Rb * g.ldb + C) * 2u; }
    const size_t kstep = (size_t)(BK * 2);
    const size_t hstepA = (size_t)HALF * g.lda * 2, hstepB = (size_t)HALF * g.ldb * 2;
    const size_t tstepA = 2 * hstepA, tstepB = 2 * hstepB;
    const unsigned ldsw = (unsigned)wid * 1024u;
    const int aoff = lds_byte(wr * 64 + fr, fq * 8), boff = lds_byte(wc * 32 + fr, fq * 8);
#define PG8_SA(b, h) (((b) * 2 + (h)) * HTB)
#define PG8_SB(b, h) ((4 + (b) * 2 + (h)) * HTB)
#define PG8_STAGE(bufoff, gbase, voff) do { _Pragma("unroll") for (int _i = 0; _i < 2; ++_i) \
        __builtin_amdgcn_global_load_lds((const unsigned*)((const char*)(gbase) + (voff)[_i]), (LAS unsigned*)(lds + (bufoff) + ldsw + _i * 8192), 16, 0, 0); } while (0)
#define PG8_LDA(dst, b, h) do { _Pragma("unroll") for (int m = 0; m < 4; ++m) _Pragma("unroll") for (int k = 0; k < 2; ++k) dst[m][k] = *(const LAS bf16x8*)(lds + PG8_SA(b, h) + aoff + m * 2048 + k * 1024); } while (0)
#define PG8_LDB(dst, b, h) do { _Pragma("unroll") for (int n = 0; n < 2; ++n) _Pragma("unroll") for (int k = 0; k < 2; ++k) dst[n][k] = *(const LAS bf16x8*)(lds + PG8_SB(b, h) + boff + n * 2048 + k * 1024); } while (0)
#define PG8_MMA(ai, bj, At, Bt) do { __builtin_amdgcn_s_setprio(1); _Pragma("unroll") for (int m = 0; m < 4; ++m) _Pragma("unroll") for (int n = 0; n < 2; ++n) _Pragma("unroll") for (int k = 0; k < 2; ++k) \
        acc[ai][bj][m][n] = __builtin_amdgcn_mfma_f32_16x16x32_bf16(Bt[n][k], At[m][k], acc[ai][bj][m][n], 0, 0, 0); __builtin_amdgcn_s_setprio(0); } while (0)
#define PG8_WAIT_V(n) asm volatile("s_waitcnt vmcnt(" #n ")" ::: "memory")
#define PG8_WAIT_L(n) asm volatile("s_waitcnt lgkmcnt(" #n ")" ::: "memory")
#define PG8_BAR __builtin_amdgcn_s_barrier()
#define PG8_SCHED __builtin_amdgcn_sched_barrier(0)
    Unit cur, nxt; int ui = 0;
    if (!S.next(0, cur)) return;
    f32x4 acc[2][2][4][2];
#pragma unroll
    for (int a = 0; a < 2; ++a)
#pragma unroll
        for (int b = 0; b < 2; ++b)
#pragma unroll
            for (int m = 0; m < 4; ++m)
#pragma unroll
                for (int n = 0; n < 2; ++n) acc[a][b][m][n] = (f32x4){0.f, 0.f, 0.f, 0.f};
    bf16x8 At[4][2], B0[2][2], B1[2][2];
    const char* cA = (const char*)g.A + (size_t)cur.pm * tstepA + (size_t)cur.pn * g.apn * 2; const char* cB = (const char*)g.Bt + (size_t)cur.pn * tstepB;
    PG8_STAGE(PG8_SB(0, 0), cB, voffB); PG8_STAGE(PG8_SA(0, 0), cA, voffA); PG8_STAGE(PG8_SB(0, 1), cB + hstepB, voffB); PG8_STAGE(PG8_SA(0, 1), cA + hstepA, voffA);
    if (wr == 1) PG8_BAR;
    PG8_WAIT_V(4); PG8_BAR;
    PG8_STAGE(PG8_SB(1, 0), cB + kstep, voffB); PG8_STAGE(PG8_SA(1, 0), cA + kstep, voffA); PG8_STAGE(PG8_SB(1, 1), cB + hstepB + kstep, voffB);
    PG8_WAIT_V(6); PG8_BAR;
    for (;;) {
        const bool has_next = S.next(ui + 1, nxt);
        if (wid == 0) E.stage(cur, ui, lds, lane);
        const char* nA = has_next ? (const char*)g.A + (size_t)nxt.pm * tstepA + (size_t)nxt.pn * g.apn * 2 : cA; const char* nB = has_next ? (const char*)g.Bt + (size_t)nxt.pn * tstepB : cB;
        for (int t = 0; t < nt; t += 2) {
            const bool last = (t == nt - 2);
            const char* a1 = cA + (size_t)(t + 1) * kstep;
            const char* a2 = last ? nA : cA + (size_t)(t + 2) * kstep; const char* b2 = last ? nB : cB + (size_t)(t + 2) * kstep;
            const char* a3 = a2 + kstep; const char* b3 = b2 + kstep;
            PG8_LDB(B0, 0, 0); PG8_SCHED; PG8_LDA(At, 0, 0); PG8_STAGE(PG8_SA(1, 1), a1 + hstepA, voffA);
            PG8_WAIT_L(8); PG8_BAR; PG8_WAIT_L(0); PG8_MMA(0, 0, At, B0); PG8_BAR; PG8_SCHED;
            PG8_LDB(B1, 0, 1); PG8_STAGE(PG8_SB(0, 0), b2, voffB);
            PG8_BAR; PG8_WAIT_L(0); PG8_MMA(0, 1, At, B1); PG8_BAR;
            PG8_LDA(At, 0, 1); PG8_STAGE(PG8_SA(0, 0), a2, voffA);
            PG8_BAR; PG8_WAIT_L(0); PG8_MMA(1, 0, At, B0); PG8_BAR; PG8_SCHED;
            PG8_STAGE(PG8_SB(0, 1), b2 + hstepB, voffB);
            PG8_WAIT_V(6); PG8_BAR; PG8_MMA(1, 1, At, B1); PG8_BAR;
            PG8_LDB(B0, 1, 0); PG8_SCHED; PG8_LDA(At, 1, 0); PG8_STAGE(PG8_SA(0, 1), a2 + hstepA, voffA);
            PG8_WAIT_L(8); PG8_BAR; PG8_WAIT_L(0); PG8_MMA(0, 0, At, B0); PG8_BAR; PG8_SCHED;
            PG8_LDB(B1, 1, 1); PG8_STAGE(PG8_SB(1, 0), b3, voffB);
            PG8_BAR; PG8_WAIT_L(0); PG8_MMA(0, 1, At, B1); PG8_BAR;
            PG8_LDA(At, 1, 1); PG8_STAGE(PG8_SA(1, 0), a3, voffA);
            PG8_BAR; PG8_WAIT_L(0); PG8_MMA(1, 0, At, B0); PG8_BAR; PG8_SCHED;
            PG8_STAGE(PG8_SB(1, 1), b3 + hstepB, voffB);
            PG8_WAIT_V(6); PG8_BAR; PG8_MMA(1, 1, At, B1); PG8_BAR;
        }
        E(acc, cur, ui, wr, wc, fr, fq);
        if (!has_next) break;
#pragma unroll
        for (int a = 0; a < 2; ++a)
#pragma unroll
            for (int b = 0; b < 2; ++b)
#pragma unroll
                for (int m = 0; m < 4; ++m)
#pragma unroll
                    for (int n = 0; n < 2; ++n) acc[a][b][m][n] = (f32x4){0.f, 0.f, 0.f, 0.f};
        cur = nxt; cA = nA; cB = nB; ++ui;
    }
    PG8_WAIT_V(0);
    if (wr == 0) PG8_BAR;
    PG8_BAR;
#undef PG8_SA
#undef PG8_SB
#undef PG8_STAGE
#undef PG8_LDA
#undef PG8_LDB
#undef PG8_MMA
#undef PG8_WAIT_V
#undef PG8_WAIT_L
#undef PG8_BAR
#undef PG8_SCHED
}

typedef f32x4 Acc[2][2][4][2];
constexpr int RSD_OFF = 131072, CV_OFF = 155648 + 256;
DI void stage_vec(LAS unsigned char* lds, const float* g256, int ui, int slot, int lane) { __builtin_amdgcn_global_load_lds((const unsigned*)(g256 + lane * 4), (LAS unsigned*)(lds + CV_OFF + (ui & 1) * 3072 + slot * 1024), 16, 0, 0); }
DI f32x4 read_vec(LAS unsigned char* lds, int ui, int slot, int col) { return *(const LAS f32x4*)(lds + CV_OFF + (ui & 1) * 3072 + slot * 1024 + col * 4); }
DI void prep_rstd(LAS unsigned char* lds, const StaticOrder& S, const float* rss) {
    LAS float* RSD = (LAS float*)(lds + RSD_OFF);
    const int tid = otid();
    for (int ui0 = tid >> 8; ui0 < 24; ui0 += 8) {
        f32x4 p[4][4]; bool ok[4];
#pragma unroll
        for (int k = 0; k < 4; ++k) { Unit u; ok[k] = S.next(ui0 + 2 * k, u);
            const f32x4* pp = (const f32x4*)(rss + (size_t)((ok[k] ? u.pm : 0) * BM + (tid & 255)) * 16);
#pragma unroll
            for (int q = 0; q < 4; ++q) p[k][q] = pp[q]; }
#pragma unroll
        for (int k = 0; k < 4; ++k) { const f32x4 a = p[k][0], b = p[k][1], c = p[k][2], d = p[k][3];
            const float s = (((a[0] + a[1]) + (a[2] + a[3])) + ((b[0] + b[1]) + (b[2] + b[3]))) + (((c[0] + c[1]) + (c[2] + c[3])) + ((d[0] + d[1]) + (d[2] + d[3])));
            if (ok[k]) RSD[(ui0 + 2 * k) * 256 + (tid & 255)] = rsqrtf(s * (1.f / D) + EPS); }
    }
    __syncthreads();
}
struct EpiCB {
    static constexpr bool PERM = true;
    float* C; int ldc;
    DI void stage(const Unit&, int, LAS unsigned char*, int) const {}
    DI void operator()(const Acc& acc, const Unit& u, int ui, int wr, int wc, int fr, int fq) const {
        if (wr != 0) return;
        const int col0 = u.pn * BM + wc * 32 + 8 * fq;
#pragma unroll
        for (int m = 0; m < 2; ++m) { float* rowp = C + (size_t)(m * 16 + fr) * ldc + col0;
#pragma unroll
            for (int bj = 0; bj < 2; ++bj)
#pragma unroll
                for (int n = 0; n < 2; ++n) *(f32x4*)(rowp + bj * HALF + n * 4) = acc[0][bj][m][n]; }
    }
};

struct EpiGeluUV {
    static constexpr bool PERM = true;
    bf16_t* U; bf16_t* V; float* stat; const float* cb; LAS float* rsd; LAS unsigned char* lds;
    DI void stage(const Unit& u, int ui, LAS unsigned char* l, int lane) const { stage_vec(l, cb + (size_t)(u.pm >> 3) * 4096 + u.pn * BM, ui, 0, lane); }
    DI void operator()(const Acc& acc, const Unit& u, int ui, int wr, int wc, int fr, int fq) const {
        const bool isV = u.pn >= 8;
        bf16_t* base = isV ? V : U;
        const int row0 = u.pm * BM + wr * 64 + fr, col0 = (u.pn & 7) * BM + wc * 32 + 8 * fq;
        f32x4 cv[2][2];
#pragma unroll
        for (int bj = 0; bj < 2; ++bj)
#pragma unroll
            for (int n = 0; n < 2; ++n) cv[bj][n] = read_vec(lds, ui, 0, bj * HALF + wc * 32 + 8 * fq + n * 4);
#pragma unroll
        for (int ai = 0; ai < 2; ++ai)
#pragma unroll
            for (int m = 0; m < 4; ++m) {
                const int row = row0 + ai * HALF + m * 16; bf16_t* rowp = base + (size_t)row * SGW + col0; float s = 0.f, q = 0.f;
                const float rs = rsd[ui * 256 + ai * HALF + wr * 64 + m * 16 + fr];
#pragma unroll
                for (int bj = 0; bj < 2; ++bj) {
                    const f32x4 v0 = acc[ai][bj][m][0] * rs + cv[bj][0], v1 = acc[ai][bj][m][1] * rs + cv[bj][1];
                    const f32x2 a = gelu_pk((f32x2){v0[0], v0[1]}), b = gelu_pk((f32x2){v0[2], v0[3]}), c = gelu_pk((f32x2){v1[0], v1[1]}), d = gelu_pk((f32x2){v1[2], v1[3]});
                    u32x4 w; w.x = cvt_pk_bf16(a.x, a.y); w.y = cvt_pk_bf16(b.x, b.y); w.z = cvt_pk_bf16(c.x, c.y); w.w = cvt_pk_bf16(d.x, d.y);
                    *(u32x4*)(rowp + bj * HALF) = w;
                    s += ((a.x + a.y) + (b.x + b.y)) + ((c.x + c.y) + (d.x + d.y));
                    q += ((a.x * a.x + a.y * a.y) + (b.x * b.x + b.y * b.y)) + ((c.x * c.x + c.y * c.y) + (d.x * d.x + d.y * d.y));
                    __builtin_amdgcn_sched_barrier(0);
                }
                if (isV) {
                    s += __shfl_xor(s, 16); s += __shfl_xor(s, 32); q += __shfl_xor(q, 16); q += __shfl_xor(q, 32);
                    if (fq == 0) *(f32x2*)(stat + ((size_t)row * 32 + (u.pn - 8) * 4 + wc) * 2) = (f32x2){s, q};
                }
                asm volatile("" ::: "memory");
            }
    }
};
struct EpiResid {
    static constexpr bool PERM = true;
    bf16_t* XG; const float* gate; const float* gsn; const float* gsc; float* rss; LAS unsigned char* lds;
    DI void stage(const Unit& u, int ui, LAS unsigned char* l, int lane) const {
        stage_vec(l, gate + (size_t)(u.pm >> 3) * 6144 + u.pn * BM, ui, 0, lane);
        if (gsn) stage_vec(l, gsn + (size_t)(u.pm >> 3) * 1024 + u.pn * BM, ui, 1, lane);
        stage_vec(l, gsc + (size_t)(u.pm >> 3) * 1024 + u.pn * BM, ui, 2, lane); }
    DI void operator()(const Acc& acc, const Unit& u, int ui, int wr, int wc, int fr, int fq) const {
        const int row0 = u.pm * BM + wr * 64 + fr, col0 = u.pn * BM + wc * 32 + 8 * fq;
        f32x4 gv[2][2];
#pragma unroll
        for (int bj = 0; bj < 2; ++bj)
#pragma unroll
            for (int n = 0; n < 2; ++n) gv[bj][n] = read_vec(lds, ui, 0, bj * HALF + wc * 32 + 8 * fq + n * 4) + 1.0f;
        float ssq[4];
#pragma unroll
        for (int ai = 0; ai < 2; ++ai) {
            u32x4 xw[4][2];
#pragma unroll
            for (int m = 0; m < 4; ++m)
#pragma unroll
                for (int bj = 0; bj < 2; ++bj) xw[m][bj] = *(const u32x4*)(XG + (size_t)(row0 + ai * HALF + m * 16) * D + col0 + bj * HALF);
#pragma unroll
            for (int bj = 0; bj < 2; ++bj) {
                f32x4 gi[2], gq[2];
#pragma unroll
                for (int n = 0; n < 2; ++n) { const int c = bj * HALF + wc * 32 + 8 * fq + n * 4; const f32x4 g = read_vec(lds, ui, 2, c);
#pragma unroll
                    for (int e = 0; e < 4; ++e) gi[n][e] = __builtin_amdgcn_rcpf(g[e]);
                    gq[n] = gsn ? read_vec(lds, ui, 1, c) : (f32x4){1.f, 1.f, 1.f, 1.f}; }
#pragma unroll
                for (int m = 0; m < 4; ++m) { const size_t off = (size_t)(row0 + ai * HALF + m * 16) * D + col0; const u32x4 xv = xw[m][bj];
                    const f32x4 x0 = (f32x4){bflo(xv.x), bfhi(xv.x), bflo(xv.y), bfhi(xv.y)} * gi[0], x1 = (f32x4){bflo(xv.z), bfhi(xv.z), bflo(xv.w), bfhi(xv.w)} * gi[1];
                    const f32x4 r0 = x0 + gv[bj][0] * acc[ai][bj][m][0], r1 = x1 + gv[bj][1] * acc[ai][bj][m][1];
                    const f32x4 y0 = r0 * gq[0], y1 = r1 * gq[1];
                    u32x4 w; w.x = cvt_pk_bf16(y0[0], y0[1]); w.y = cvt_pk_bf16(y0[2], y0[3]); w.z = cvt_pk_bf16(y1[0], y1[1]); w.w = cvt_pk_bf16(y1[2], y1[3]);
                    *(u32x4*)(XG + off + bj * HALF) = w;
                    const float ssp = ((r0[0] * r0[0] + r0[1] * r0[1]) + (r0[2] * r0[2] + r0[3] * r0[3])) + ((r1[0] * r1[0] + r1[1] * r1[1]) + (r1[2] * r1[2] + r1[3] * r1[3]));
                    if (bj == 0) ssq[m] = ssp; else ssq[m] += ssp; } }
            if (gsn) {
#pragma unroll
                for (int m = 0; m < 4; ++m) { float ss = ssq[m]; ss += __shfl_xor(ss, 16); ss += __shfl_xor(ss, 32); if (fq == 0) rss[(size_t)(row0 + ai * HALF + m * 16) * 16 + u.pn * 4 + wc] = ss; } }
            asm volatile("" ::: "memory"); }
    }
};
struct EpiBf16 {
    static constexpr bool PERM = true;
    bf16_t* O; int ldc; const float* bias; const float* scale; const float* cb; LAS float* rsd; LAS unsigned char* lds;
    DI void stage(const Unit& u, int ui, LAS unsigned char* l, int lane) const { stage_vec(l, cb ? cb + (size_t)(u.pm >> 3) * ldc + u.pn * BM : bias + u.pn * BM, ui, 0, lane); if (scale) stage_vec(l, scale + u.pn * BM, ui, 1, lane); }
    DI void operator()(const Acc& acc, const Unit& u, int ui, int wr, int wc, int fr, int fq) const {
        const int row0 = u.pm * BM + wr * 64 + fr, col0 = u.pn * BM + wc * 32 + 8 * fq;
        f32x4 bv[2][2], sv[2][2];
#pragma unroll
        for (int bj = 0; bj < 2; ++bj)
#pragma unroll
            for (int n = 0; n < 2; ++n) { bv[bj][n] = read_vec(lds, ui, 0, bj * HALF + wc * 32 + 8 * fq + 4 * n);
                sv[bj][n] = scale ? read_vec(lds, ui, 1, bj * HALF + wc * 32 + 8 * fq + 4 * n) : (f32x4){1.f, 1.f, 1.f, 1.f}; }
#pragma unroll
        for (int ai = 0; ai < 2; ++ai)
#pragma unroll
            for (int m = 0; m < 4; ++m) { bf16_t* rowp = O + (size_t)(row0 + ai * HALF + m * 16) * ldc + col0;
                const float rs = cb ? rsd[ui * 256 + ai * HALF + wr * 64 + m * 16 + fr] : 1.0f;
#pragma unroll
                for (int bj = 0; bj < 2; ++bj) { const f32x4 v0 = (acc[ai][bj][m][0] * rs + bv[bj][0]) * sv[bj][0], v1 = (acc[ai][bj][m][1] * rs + bv[bj][1]) * sv[bj][1];
                    u32x4 w; w.x = cvt_pk_bf16(v0[0], v0[1]); w.y = cvt_pk_bf16(v0[2], v0[3]); w.z = cvt_pk_bf16(v1[0], v1[1]); w.w = cvt_pk_bf16(v1[2], v1[3]);
                    *(u32x4*)(rowp + bj * HALF) = w; } }
    }
};
struct EpiRet {
    static constexpr bool PERM = true;
    bf16_t* Q; bf16_t* Kb; bf16_t* V; bf16_t* G; const float* cosT; const float* sinT; const float* cb; LAS float* rsd; LAS unsigned char* lds;
    DI void stage(const Unit& u, int ui, LAS unsigned char* l, int lane) const { stage_vec(l, cb + (size_t)(u.pm >> 3) * RETIN + u.pn * BM, ui, 0, lane); }
    DI void operator()(const Acc& acc, const Unit& u, int ui, int wr, int wc, int fr, int fq) const {
        const int row0 = u.pm * BM + wr * 64 + fr, cw = wc * 32 + 8 * fq;
        f32x4 cv[2][2];
#pragma unroll
        for (int bj = 0; bj < 2; ++bj)
#pragma unroll
            for (int n = 0; n < 2; ++n) cv[bj][n] = read_vec(lds, ui, 0, bj * HALF + cw + n * 4);
        if (u.pn < 8) {
            bf16_t* base = (u.pn < 4 ? Q : Kb) + (u.pn & 3) * 256 + cw; const float sc = u.pn < 4 ? 1.0f : 0.0625f;
#pragma unroll
            for (int ai = 0; ai < 2; ++ai)
#pragma unroll
                for (int m = 0; m < 4; ++m) { const int row = row0 + ai * HALF + m * 16, pos = row & (SEQ - 1);
                    const f32x4 c0 = *(const f32x4*)(cosT + pos * 128 + cw), c1 = *(const f32x4*)(cosT + pos * 128 + cw + 4);
                    const f32x4 s0 = *(const f32x4*)(sinT + pos * 128 + cw), s1 = *(const f32x4*)(sinT + pos * 128 + cw + 4);
                    const float rs = rsd[ui * 256 + ai * HALF + wr * 64 + m * 16 + fr];
                    const f32x4 x10 = acc[ai][0][m][0] * rs + cv[0][0], x11 = acc[ai][0][m][1] * rs + cv[0][1], x20 = acc[ai][1][m][0] * rs + cv[1][0], x21 = acc[ai][1][m][1] * rs + cv[1][1];
                    const f32x4 o10 = (x10 * c0 - x20 * s0) * sc, o11 = (x11 * c1 - x21 * s1) * sc, o20 = (x20 * c0 + x10 * s0) * sc, o21 = (x21 * c1 + x11 * s1) * sc;
                    u32x4 w1, w2; w1.x = cvt_pk_bf16(o10[0], o10[1]); w1.y = cvt_pk_bf16(o10[2], o10[3]); w1.z = cvt_pk_bf16(o11[0], o11[1]); w1.w = cvt_pk_bf16(o11[2], o11[3]);
                    w2.x = cvt_pk_bf16(o20[0], o20[1]); w2.y = cvt_pk_bf16(o20[2], o20[3]); w2.z = cvt_pk_bf16(o21[0], o21[1]); w2.w = cvt_pk_bf16(o21[2], o21[3]);
                    *(u32x4*)(base + (size_t)row * 1024) = w1; *(u32x4*)(base + (size_t)row * 1024 + HALF) = w2; }
        } else {
            const bool isG = u.pn >= 16;
            bf16_t* base = (isG ? G : V) + ((u.pn - 8) & 7) * 256 + cw;
#pragma unroll
            for (int ai = 0; ai < 2; ++ai)
#pragma unroll
                for (int m = 0; m < 4; ++m) { bf16_t* rowp = base + (size_t)(row0 + ai * HALF + m * 16) * 2048;
                    const float rs = rsd[ui * 256 + ai * HALF + wr * 64 + m * 16 + fr];
#pragma unroll
                    for (int bj = 0; bj < 2; ++bj) { f32x4 v0 = acc[ai][bj][m][0] * rs + cv[bj][0], v1 = acc[ai][bj][m][1] * rs + cv[bj][1];
                        if (isG) {
#pragma unroll
                            for (int e = 0; e < 4; ++e) { v0[e] = silu_f(v0[e]); v1[e] = silu_f(v1[e]); } }
                        u32x4 w; w.x = cvt_pk_bf16(v0[0], v0[1]); w.y = cvt_pk_bf16(v0[2], v0[3]); w.z = cvt_pk_bf16(v1[0], v1[1]); w.w = cvt_pk_bf16(v1[2], v1[3]);
                        *(u32x4*)(rowp + bj * HALF) = w; } }
        }
    }
};
struct EpiGate {
    static constexpr bool PERM = true;
    bf16_t* A2; const bf16_t* Ob; const float* nstat; const float* cb; LAS float* rsd; LAS unsigned char* lds;
    DI void stage(const Unit& u, int ui, LAS unsigned char* l, int lane) const { stage_vec(l, cb + (size_t)(u.pm >> 3) * RETIN + 4096 + u.pn * BM, ui, 0, lane); }
    DI void operator()(const Acc& acc, const Unit& u, int ui, int wr, int wc, int fr, int fq) const {
        const int row0 = u.pm * BM + wr * 64 + fr, col0 = u.pn * BM + wc * 32 + 8 * fq, h = u.pn >> 1;
        f32x4 cv[2][2];
#pragma unroll
        for (int bj = 0; bj < 2; ++bj)
#pragma unroll
            for (int n = 0; n < 2; ++n) cv[bj][n] = read_vec(lds, ui, 0, bj * HALF + wc * 32 + 8 * fq + n * 4);
#pragma unroll
        for (int am = 0; am < 4; ++am) { const int ai = am >> 1, mb = (am & 1) * 2;
            u32x4 ow[4][2]; f32x2 ns[4];
#pragma unroll
            for (int m = mb; m < mb + 2; ++m) { const int row = row0 + ai * HALF + m * 16; ns[m] = *(const f32x2*)(nstat + ((size_t)row * 4 + h) * 2);
#pragma unroll
                for (int bj = 0; bj < 2; ++bj) ow[m][bj] = *(const u32x4*)(Ob + (size_t)row * 2048 + col0 + bj * HALF); }
#pragma unroll
            for (int m = mb; m < mb + 2; ++m) { const int row = row0 + ai * HALF + m * 16;
                const float rs = rsd[ui * 256 + ai * HALF + wr * 64 + m * 16 + fr], on = rsqrtf((ns[m].x + ns[m].y) * (1.f / 512.f) + EPS);
#pragma unroll
                for (int bj = 0; bj < 2; ++bj) { const u32x4 ov = ow[m][bj];
                    const f32x4 g0 = acc[ai][bj][m][0] * rs + cv[bj][0], g1 = acc[ai][bj][m][1] * rs + cv[bj][1];
                    const f32x4 o0 = (f32x4){bflo(ov.x), bfhi(ov.x), bflo(ov.y), bfhi(ov.y)} * on, o1 = (f32x4){bflo(ov.z), bfhi(ov.z), bflo(ov.w), bfhi(ov.w)} * on;
                    f32x4 y0, y1;
#pragma unroll
                    for (int e = 0; e < 4; ++e) { y0[e] = silu_f(g0[e]) * o0[e]; y1[e] = silu_f(g1[e]) * o1[e]; }
                    u32x4 w; w.x = cvt_pk_bf16(y0[0], y0[1]); w.y = cvt_pk_bf16(y0[2], y0[3]); w.z = cvt_pk_bf16(y1[0], y1[1]); w.w = cvt_pk_bf16(y1[2], y1[3]);
                    *(u32x4*)(A2 + (size_t)row * 2048 + col0 + bj * HALF) = w; } }
            asm volatile("" ::: "memory"); }
    }
};
struct EpiSwiglu {
    static constexpr bool PERM = true;
    bf16_t* O; const float* cb; LAS float* rsd; LAS unsigned char* lds;
    DI void stage(const Unit& u, int ui, LAS unsigned char* l, int lane) const { stage_vec(l, cb + (size_t)(u.pm >> 3) * (2 * DFF) + u.pn * BM, ui, 0, lane); }
    DI void operator()(const Acc& acc, const Unit& u, int ui, int wr, int wc, int fr, int fq) const {
        const int row0 = u.pm * BM + wr * 64 + fr, col0 = u.pn * HALF + wc * 32 + 8 * fq;
        f32x4 cv[2][2];
#pragma unroll
        for (int bj = 0; bj < 2; ++bj)
#pragma unroll
            for (int n = 0; n < 2; ++n) cv[bj][n] = read_vec(lds, ui, 0, bj * HALF + wc * 32 + 8 * fq + n * 4);
        float rsv[2][4];
#pragma unroll
        for (int ai = 0; ai < 2; ++ai)
#pragma unroll
            for (int m = 0; m < 4; ++m) rsv[ai][m] = rsd[ui * 256 + ai * HALF + wr * 64 + m * 16 + fr];
#pragma unroll
        for (int ai = 0; ai < 2; ++ai)
#pragma unroll
            for (int m = 0; m < 4; ++m) { bf16_t* rowp = O + (size_t)(row0 + ai * HALF + m * 16) * DFF + col0;
                const float rs = rsv[ai][m];
                unsigned wv[4];
#pragma unroll
                for (int n = 0; n < 2; ++n)
#pragma unroll
                    for (int hh = 0; hh < 2; ++hh) {
                        const f32x2 ar = {acc[ai][0][m][n][2 * hh], acc[ai][0][m][n][2 * hh + 1]}, br = {acc[ai][1][m][n][2 * hh], acc[ai][1][m][n][2 * hh + 1]};
                        const f32x2 ca = {cv[0][n][2 * hh], cv[0][n][2 * hh + 1]}, cb2 = {cv[1][n][2 * hh], cv[1][n][2 * hh + 1]};
                        const f32x2 a2 = ar * rs + ca, b2 = br * rs + cb2;
                        const f32x2 t = a2 * (-1.44269504089f);
                        f32x2 e; e.x = __builtin_amdgcn_exp2f(t.x); e.y = __builtin_amdgcn_exp2f(t.y);
                        const f32x2 d = e + 1.0f;
                        f32x2 r; r.x = __builtin_amdgcn_rcpf(d.x); r.y = __builtin_amdgcn_rcpf(d.y);
                        const f32x2 o = (a2 * r) * b2;
                        wv[2 * n + hh] = cvt_pk_bf16(o.x, o.y); }
                u32x4 w; w.x = wv[0]; w.y = wv[1]; w.z = wv[2]; w.w = wv[3];
                *(u32x4*)rowp = w; }
    }
};
}

struct Args {
    const float* in[21];
    float* out;
    unsigned char* ws;
    int ph_lo, ph_hi;
};

DI void transpose_item(const float* W, int K, int N, bf16_t* WT, int kb, int ns0, int nd0, LAS float* scr, int lane) {
    const int k0 = 64 * kb;
    float wv[32];
#pragma unroll
    for (int i = 0; i < 32; ++i) wv[i] = W[(size_t)(k0 + 2 * i + (lane >> 5)) * N + ns0 + (lane & 31)];
#pragma unroll
    for (int i = 0; i < 32; ++i) scr[(2 * i + (lane >> 5)) * 33 + (lane & 31)] = wv[i];
    asm volatile("s_waitcnt lgkmcnt(0)" ::: "memory");
    const int c = lane & 7;
#pragma unroll
    for (int j = 0; j < 4; ++j) { const int n = (lane >> 3) + 8 * j; const LAS float* s = scr + (8 * c) * 33 + n;
        u32x4 o; o.x = cvt_pk_bf16(s[0 * 33], s[1 * 33]); o.y = cvt_pk_bf16(s[2 * 33], s[3 * 33]); o.z = cvt_pk_bf16(s[4 * 33], s[5 * 33]); o.w = cvt_pk_bf16(s[6 * 33], s[7 * 33]);
        *(u32x4*)(WT + (size_t)(nd0 + n) * K + k0 + 8 * c) = o; }
    asm volatile("s_waitcnt lgkmcnt(0)" ::: "memory");
}
DI bool transpose_set(int& r, const float* W, int K, int N, int nmat, bf16_t* WT, LAS float* scr, int lane) {
    const int per = (K / 64) * (N / 32), tot = per * nmat;
    if (r >= tot) { r -= tot; return false; }
    const int mi = r / per, it = r % per, nblk = N / 32, kb = it / nblk, nb = it % nblk;
    transpose_item(W + (size_t)mi * K * N, K, N, WT + (size_t)mi * K * N, kb, 32 * nb, 32 * nb, scr, lane);
    return true;
}

DI void phase_prep(const Args& a, LAS unsigned char* lds) {
    const int tid = otid(), lane = tid & 63, wave = tid >> 6, G = gridDim.x, bid = obid();
    unsigned char* ws = a.ws;
    if (bid < 192) {
        LAS float* sc = (LAS float*)lds;
        LAS float* red = (LAS float*)(lds + 131072);
        const float* c = a.in[1];
        for (int i0 = tid; i0 < 32 * 1024; i0 += 16 * NTHR) { float cv_[16];
#pragma unroll
            for (int u = 0; u < 16; ++u) cv_[u] = c[i0 + u * NTHR];
#pragma unroll
            for (int u = 0; u < 16; ++u) { const int i = i0 + u * NTHR, b = i >> 10, k = i & 1023; sc[k * 32 + b] = silu_f(cv_[u]); } }
        for (int i = tid; i < 32 * 128; i += NTHR) red[i] = 0.f;
        __syncthreads();
        const int l = bid / 48, n0 = (bid % 48) * 128, col = tid & 127, kq = tid >> 7;
        const float* W = a.in[4] + (size_t)l * D * 6144 + n0 + col;
        float acc[32];
#pragma unroll
        for (int b = 0; b < 32; ++b) acc[b] = 0.f;
        for (int k0 = kq * 256; k0 < kq * 256 + 256; k0 += 32) {
            float wv[32];
#pragma unroll
            for (int u = 0; u < 32; ++u) wv[u] = W[(size_t)(k0 + u) * 6144];
#pragma unroll
            for (int u = 0; u < 32; ++u) {
                const float w = wv[u];
                const LAS f32x4* s4 = (const LAS f32x4*)(sc + (k0 + u) * 32);
#pragma unroll
                for (int j = 0; j < 8; ++j) { const f32x4 s = s4[j]; acc[4 * j] += w * s[0]; acc[4 * j + 1] += w * s[1]; acc[4 * j + 2] += w * s[2]; acc[4 * j + 3] += w * s[3]; }
            }
        }
        for (int r = 0; r < 4; ++r) {
            if (kq == r) {
#pragma unroll
                for (int b = 0; b < 32; ++b) red[b * 128 + col] = (r == 0 ? 0.f : red[b * 128 + col]) + acc[b]; }
            __syncthreads(); }
        float* mod = (float*)(ws + WS_MOD) + (size_t)l * 32 * 6144 + n0;
        const float* bias = a.in[5] + (size_t)l * 6144 + n0;
        const int seg = n0 >> 10;
        bf16_t* shb = (bf16_t*)(ws + WS_SHB) + (size_t)(32 * (2 * l + (seg == 3))) * 1024 + (n0 & 1023);
        float* gs = (float*)(ws + WS_GS) + (size_t)(2 * l + (seg == 4)) * 32 * 1024 + (n0 & 1023);
        const float* ng = a.in[seg == 1 ? 2 : 3] + l * D + (n0 & 1023);
        for (int i = tid; i < 32 * 128; i += NTHR) { const int b = i >> 7, n = i & 127; const float v = red[i] + bias[n]; mod[(size_t)b * 6144 + n] = v;
            if (seg == 0 || seg == 3) shb[(size_t)b * 1024 + n] = (bf16_t)(cvt_pk_bf16(v, 0.f) & 0xffffu);
            if (seg == 1 || seg == 4) gs[(size_t)b * 1024 + n] = ng[n] * (1.0f + v); }
        __syncthreads();
    }
    if (bid == 255) { unsigned* bw = (unsigned*)(ws + WS_BAR); for (int i = tid; i < 4096; i += NTHR) bw[i] = 0u; }
    {
        const size_t gt = (size_t)bid * NTHR + tid, GT = (size_t)G * NTHR;
        float* cosT = (float*)(ws + WS_ROPE); float* sinT = cosT + SEQ * 128;
        for (size_t i = gt; i < (size_t)SEQ * 128; i += GT) { const int pos = (int)(i >> 7), fi = (int)(i & 127);
            const float inv = exp2f(-(float)fi * (13.287712379549449f / 128.0f)); const float ang = (float)pos * inv;
            const double rev = (double)ang * 0.15915494309189535; const float fr = (float)(rev - rint(rev));
            cosT[i] = __builtin_amdgcn_cosf(fr); sinT[i] = __builtin_amdgcn_sinf(fr); }
        bf16_t* wsg = (bf16_t*)(ws + WS_W_SG_S); const float* w_s = a.in[10];
        for (size_t i = gt; i < (size_t)2 * 8 * 128 * 128; i += GT) { const int ii = (int)((i >> 7) & 127), jj = (int)(i & 127);
            const float v = ((ii >> 6) >= (jj >> 6)) ? w_s[i] : 0.f; wsg[i] = (bf16_t)(cvt_pk_bf16(v, 0.f) & 0xffffu); }
    }
    {
        LAS float* scr = (LAS float*)(lds + wave * 16384);
        const int gw = bid * 8 + wave, NGW = G * 8;
        constexpr int I_FI = (D / 64) * (2 * DFF / 32) * 4, I_FO = (DFF / 64) * (D / 32) * 4, I_SI = (D / 64) * (4096 / 32) * 2, I_SO = (SGW / 64) * (D / 32) * 2,
                      I_PI = (D / 64) * (D / 32), I_PG = (256 / 64) * (256 / 32) * 4, I_PO = I_PI, I_RI = (D / 64) * (RETIN / 32), I_RO = (2048 / 64) * (D / 32);
        constexpr int NITEMS = I_FI + I_FO + I_SI + I_SO + I_PI + I_PG + I_PO + I_RI + I_RO;
        for (int it = gw; it < NITEMS; it += NGW) {
            int r = it;
            if (r < I_FI) {
                const int per = (D / 64) * (2 * DFF / 32), l = r / per, q = r % per, nblk = 2 * DFF / 32, kb = q / nblk, nb = q % nblk, rd = 32 * nb;
                const int ns0 = ((rd & 255) >> 7) * DFF + 128 * (rd >> 8) + (rd & 127);
                transpose_item(a.in[6] + (size_t)l * D * 2 * DFF, D, 2 * DFF, (bf16_t*)(ws + WS_W_FFN_IN) + (size_t)l * D * 2 * DFF, kb, ns0, rd, scr, lane);
                continue; }
            r -= I_FI;
            if (transpose_set(r, a.in[7], DFF, D, 4, (bf16_t*)(ws + WS_W_FFN_OUT), scr, lane)) continue;
            if (transpose_set(r, a.in[8], D, 4096, 2, (bf16_t*)(ws + WS_W_SG_IN), scr, lane)) continue;
            if (transpose_set(r, a.in[12], SGW, D, 2, (bf16_t*)(ws + WS_W_SG_OUT), scr, lane)) continue;
            if (transpose_set(r, a.in[13], D, D, 1, (bf16_t*)(ws + WS_W_POOL_IN), scr, lane)) continue;
            if (transpose_set(r, a.in[14], 256, 256, 4, (bf16_t*)(ws + WS_W_POOL_GRP), scr, lane)) continue;
            if (transpose_set(r, a.in[17], D, D, 1, (bf16_t*)(ws + WS_W_POOL_OUT), scr, lane)) continue;
            if (transpose_set(r, a.in[18], D, RETIN, 1, (bf16_t*)(ws + WS_W_RET_IN), scr, lane)) continue;
            transpose_set(r, a.in[19], 2048, D, 1, (bf16_t*)(ws + WS_W_RET_OUT), scr, lane);
        }
    }
}

DI void phase_xg0(const float* x, const float* gs, bf16_t* XG, float* rss) {
    const int tid_ = otid(), lane = tid_ & 63, gw = obid() * 8 + (tid_ >> 6), NGW = gridDim.x * 8;
    for (int row0 = gw * 4; row0 < MTOK; row0 += NGW * 4) {
        const int b = row0 >> 11;
        f32x4 v[4][4];
#pragma unroll
        for (int r = 0; r < 4; ++r)
#pragma unroll
            for (int j = 0; j < 4; ++j) v[r][j] = *((const f32x4*)(x + (size_t)(row0 + r) * D) + lane + 64 * j);
#pragma unroll
        for (int r = 0; r < 4; ++r) { float s = 0.f;
#pragma unroll
            for (int j = 0; j < 4; ++j) s += (v[r][j].x * v[r][j].x + v[r][j].y * v[r][j].y) + (v[r][j].z * v[r][j].z + v[r][j].w * v[r][j].w);
            s = wave_sum(s);
            if (lane < 16) rss[(size_t)(row0 + r) * 16 + lane] = lane == 0 ? s : 0.f; }
#pragma unroll
        for (int j = 0; j < 4; ++j) { const int col = 4 * lane + 256 * j;
            const f32x4 g4 = *(const f32x4*)(gs + (size_t)b * 1024 + col);
#pragma unroll
            for (int r = 0; r < 4; ++r) { const f32x4 h = v[r][j] * g4;
                u32x2 w; w.x = cvt_pk_bf16(h[0], h[1]); w.y = cvt_pk_bf16(h[2], h[3]); *((u32x2*)(XG + (size_t)(row0 + r) * D) + lane + 64 * j) = w; } }
    }
}
DI void phase_final_norm(const bf16_t* xb, const float* g, float* out) {
    const int tid_ = otid(), lane = tid_ & 63, gw = obid() * 8 + (tid_ >> 6), NGW = gridDim.x * 8;
    for (int row0 = gw * 4; row0 < MTOK; row0 += NGW * 4) {
        u32x4 w[4][2]; float rstd[4];
#pragma unroll
        for (int r = 0; r < 4; ++r)
#pragma unroll
            for (int j = 0; j < 2; ++j) w[r][j] = *((const u32x4*)(xb + (size_t)(row0 + r) * D) + lane + 64 * j);
#pragma unroll
        for (int r = 0; r < 4; ++r) { float s = 0.f;
#pragma unroll
            for (int j = 0; j < 2; ++j) { const u32x4 v = w[r][j];
                s += ((bflo(v.x) * bflo(v.x) + bfhi(v.x) * bfhi(v.x)) + (bflo(v.y) * bflo(v.y) + bfhi(v.y) * bfhi(v.y))) + ((bflo(v.z) * bflo(v.z) + bfhi(v.z) * bfhi(v.z)) + (bflo(v.w) * bflo(v.w) + bfhi(v.w) * bfhi(v.w))); }
            rstd[r] = rsqrtf(wave_sum(s) * (1.f / D) + EPS); }
#pragma unroll
        for (int j = 0; j < 2; ++j) { const int col = 8 * lane + 512 * j;
            const f32x4 g0 = *(const f32x4*)(g + col), g1 = *(const f32x4*)(g + col + 4);
#pragma unroll
            for (int r = 0; r < 4; ++r) { const u32x4 v = w[r][j]; float* o = out + (size_t)(row0 + r) * D + col;
                *(f32x4*)o = (f32x4){bflo(v.x), bfhi(v.x), bflo(v.y), bfhi(v.y)} * rstd[r] * g0;
                *(f32x4*)(o + 4) = (f32x4){bflo(v.z), bfhi(v.z), bflo(v.w), bfhi(v.w)} * rstd[r] * g1; } }
    }
}

DI void phase_sg(LAS unsigned char* lds, const bf16_t* U, const bf16_t* V, const float* stat, const float* gam, const bf16_t* Wm, const float* bs, bf16_t* O) {
    constexpr int WST = 272, VST = 272;
    LAS unsigned char* WI = lds; LAS unsigned char* VT = lds + 128 * WST; LAS f32x2* ST = (LAS f32x2*)(VT + 256 * VST);
    const int tid = otid(), bid = obid(), lane = tid & 63, wid = tid >> 6, wr = wid >> 2, wc = wid & 3, fr = lane & 15, fq = lane >> 4;
    const int g = bid & 7, G = gridDim.x;
    for (int p = tid; p < 128 * 16; p += NTHR) { const int i = p >> 4, jc = p & 15; *(LAS u32x4*)(WI + i * WST + jc * 16) = *(const u32x4*)(Wm + (size_t)g * 16384 + i * 128 + jc * 8); }
    u32x4 vw[2][4]; f32x4 sp[4]; f32x2 stn = (f32x2){0.f, 0.f};
    const f32x4 gm0 = *(const f32x4*)(gam + 256 * g + 8 * (tid & 31)), gm1 = *(const f32x4*)(gam + 256 * g + 8 * (tid & 31) + 4);
#define SG_LOADV(item) do { const int tk0_ = ((item) >> 3) * 128; _Pragma("unroll") for (int q = 0; q < 2; ++q) { const int task = tid + q * NTHR, cgp = task & 31, jg = task >> 5; \
        _Pragma("unroll") for (int r = 0; r < 4; ++r) vw[q][r] = *(const u32x4*)(V + (size_t)(tk0_ + 4 * jg + r) * SGW + 256 * g + 8 * cgp); } } while (0)
#define SG_LOADS(item) do { const f32x4* pp_ = (const f32x4*)(stat + (size_t)(((item) >> 3) * 128 + (tid >> 2)) * 64) + (tid & 3) * 4; _Pragma("unroll") for (int k = 0; k < 4; ++k) sp[k] = pp_[k]; } while (0)
#define SG_REDS() do { float s_ = ((sp[0][0] + sp[0][2]) + (sp[1][0] + sp[1][2])) + ((sp[2][0] + sp[2][2]) + (sp[3][0] + sp[3][2])), q_ = ((sp[0][1] + sp[0][3]) + (sp[1][1] + sp[1][3])) + ((sp[2][1] + sp[2][3]) + (sp[3][1] + sp[3][3])); \
        s_ += __shfl_xor(s_, 1); q_ += __shfl_xor(q_, 1); s_ += __shfl_xor(s_, 2); q_ += __shfl_xor(q_, 2); \
        const float mu_ = s_ * (1.f / SGW), var_ = q_ * (1.f / SGW) - mu_ * mu_; stn = (f32x2){mu_, rsqrtf(fmaxf(var_, 0.f) + EPS)}; } while (0)
    if (bid < 4096) { SG_LOADV(bid); SG_LOADS(bid); SG_REDS(); }
    for (int it = bid; it < 4096; it += G) {
        const int nb = it >> 3; const int tok0 = nb * 128; const bool more = it + G < 4096;
        if ((tid & 3) == 0) ST[tid >> 2] = stn;
        __syncthreads();
#pragma unroll
        for (int q = 0; q < 2; ++q) {
            const int task = tid + q * NTHR, cgp = task & 31, jg = task >> 5;
            const f32x4 g0 = gm0, g1 = gm1;
            float vals[4][8];
#pragma unroll
            for (int r = 0; r < 4; ++r) { const u32x4 w = vw[q][r];
                const f32x2 st = ST[4 * jg + r]; const float mu = st.x, rstd = st.y;
                vals[r][0] = (bflo(w.x) - mu) * rstd * g0[0]; vals[r][1] = (bfhi(w.x) - mu) * rstd * g0[1]; vals[r][2] = (bflo(w.y) - mu) * rstd * g0[2]; vals[r][3] = (bfhi(w.y) - mu) * rstd * g0[3];
                vals[r][4] = (bflo(w.z) - mu) * rstd * g1[0]; vals[r][5] = (bfhi(w.z) - mu) * rstd * g1[1]; vals[r][6] = (bflo(w.w) - mu) * rstd * g1[2]; vals[r][7] = (bfhi(w.w) - mu) * rstd * g1[3]; }
#pragma unroll
            for (int cc = 0; cc < 8; ++cc) { u32x2 w; w.x = cvt_pk_bf16(vals[0][cc], vals[1][cc]); w.y = cvt_pk_bf16(vals[2][cc], vals[3][cc]);
                *(LAS u32x2*)(VT + (8 * cgp + cc) * VST + 8 * (jg ^ (2 * (cgp & 7)))) = w; }
        }
        __syncthreads();
        u32x4 uw[4][2];
#pragma unroll
        for (int t = 0; t < 4; ++t)
#pragma unroll
            for (int p2 = 0; p2 < 2; ++p2) uw[t][p2] = *(const u32x4*)(U + (size_t)(tok0 + 64 * wr + 16 * t + fr) * SGW + 256 * g + 64 * wc + 32 * p2 + 8 * fq);
        if (more) { SG_LOADV(it + G); SG_LOADS(it + G); }
        f32x4 acc[2][2][4];
#pragma unroll
        for (int p2 = 0; p2 < 2; ++p2)
#pragma unroll
            for (int q = 0; q < 2; ++q)
#pragma unroll
                for (int t = 0; t < 4; ++t) acc[p2][q][t] = (f32x4){0.f, 0.f, 0.f, 0.f};
        const int nks = wr ? 4 : 2;
        for (int ks = 0; ks < nks; ++ks) {
            bf16x8 bw[4], av[2][2];
#pragma unroll
            for (int t = 0; t < 4; ++t) bw[t] = *(const LAS bf16x8*)(WI + (64 * wr + 16 * t + fr) * WST + (32 * ks + 8 * fq) * 2);
#pragma unroll
            for (int p2 = 0; p2 < 2; ++p2)
#pragma unroll
                for (int q = 0; q < 2; ++q) av[p2][q] = *(const LAS bf16x8*)(VT + (32 * (2 * wc + p2) + 8 * (fr >> 2) + 4 * q + (fr & 3)) * VST + 64 * ((ks & 1) ^ p2) + 128 * (ks >> 1) + 16 * (fq ^ (fr >> 2)));
#pragma unroll
            for (int p2 = 0; p2 < 2; ++p2)
#pragma unroll
                for (int q = 0; q < 2; ++q)
#pragma unroll
                    for (int t = 0; t < 4; ++t) acc[p2][q][t] = __builtin_amdgcn_mfma_f32_16x16x32_bf16(av[p2][q], bw[t], acc[p2][q][t], 0, 0, 0);
        }
#pragma unroll
        for (int t = 0; t < 4; ++t) { const int i = 64 * wr + 16 * t + fr; const float bias = bs[g * 128 + i];
#pragma unroll
            for (int p2 = 0; p2 < 2; ++p2) { const size_t off = (size_t)(tok0 + i) * SGW + 256 * g + 64 * wc + 32 * p2 + 8 * fq;
                const u32x4 u4 = uw[t][p2]; const f32x4 a0 = acc[p2][0][t] + bias, a1 = acc[p2][1][t] + bias;
                u32x4 w; w.x = cvt_pk_bf16(bflo(u4.x) * a0[0], bfhi(u4.x) * a0[1]); w.y = cvt_pk_bf16(bflo(u4.y) * a0[2], bfhi(u4.y) * a0[3]);
                w.z = cvt_pk_bf16(bflo(u4.z) * a1[0], bfhi(u4.z) * a1[1]); w.w = cvt_pk_bf16(bflo(u4.w) * a1[2], bfhi(u4.w) * a1[3]);
                *(u32x4*)(O + off) = w; } }
        if (more) SG_REDS();
    }
#undef SG_LOADV
#undef SG_LOADS
#undef SG_REDS
}

DI void phase_pool(const bf16_t* Z, bf16_t* P) {
    const int gtid = obid() * NTHR + otid(), GT = gridDim.x * NTHR;
    for (int task = gtid; task < (MTOK / 64) * 128; task += GT) {
        const int cg8 = task & 127, run = task >> 7, ch = 8 * cg8, win = 2 << (ch >> 8);
        const int tok0 = run * 64, t0 = tok0 & (SEQ - 1);
        float s[8];
#pragma unroll
        for (int e = 0; e < 8; ++e) s[e] = 0.f;
        for (int d = 1; d < win; ++d) { if (t0 - d >= 0) { const u32x4 w = *(const u32x4*)(Z + (size_t)(tok0 - d) * D + ch);
            s[0] += bflo(w.x); s[1] += bfhi(w.x); s[2] += bflo(w.y); s[3] += bfhi(w.y); s[4] += bflo(w.z); s[5] += bfhi(w.z); s[6] += bflo(w.w); s[7] += bfhi(w.w); } }
        for (int i0 = 0; i0 < 64; i0 += 8) {
            u32x4 wn[8], wo[8];
#pragma unroll
            for (int u = 0; u < 8; ++u) { wn[u] = *(const u32x4*)(Z + (size_t)(tok0 + i0 + u) * D + ch);
                const int tl = t0 + i0 + u - win + 1; wo[u] = tl >= 0 ? *(const u32x4*)(Z + (size_t)(tok0 + i0 + u - win + 1) * D + ch) : (u32x4){0u, 0u, 0u, 0u}; }
#pragma unroll
            for (int u = 0; u < 8; ++u) { const int t = t0 + i0 + u; const u32x4 w = wn[u];
                float z[8] = {bflo(w.x), bfhi(w.x), bflo(w.y), bfhi(w.y), bflo(w.z), bfhi(w.z), bflo(w.w), bfhi(w.w)};
#pragma unroll
                for (int e = 0; e < 8; ++e) s[e] += z[e];
                const float rc = 1.0f / (float)(t + 1 < win ? t + 1 : win);
                u32x4 o; o.x = cvt_pk_bf16(s[0] * rc - z[0], s[1] * rc - z[1]); o.y = cvt_pk_bf16(s[2] * rc - z[2], s[3] * rc - z[3]);
                o.z = cvt_pk_bf16(s[4] * rc - z[4], s[5] * rc - z[5]); o.w = cvt_pk_bf16(s[6] * rc - z[6], s[7] * rc - z[7]);
                *(u32x4*)(P + (size_t)(tok0 + i0 + u) * D + ch) = o;
                const u32x4 x = wo[u];
                s[0] -= bflo(x.x); s[1] -= bfhi(x.x); s[2] -= bflo(x.y); s[3] -= bfhi(x.y); s[4] -= bflo(x.z); s[5] -= bfhi(x.z); s[6] -= bflo(x.w); s[7] -= bfhi(x.w); }
        }
    }
}

DI void phase_ret(LAS unsigned char* lds, const bf16_t* Qb, const bf16_t* Kb, bf16_t* VO, float* nstat) {
    constexpr int QST = 528, TST = 144;
    LAS unsigned char* QI = lds; LAS unsigned char* KI = lds + 64 * QST; LAS unsigned char* KT = KI + 64 * QST; LAS unsigned char* VT = KT + 256 * TST;
    LAS unsigned char* PI = VT + 256 * TST; LAS float* RS = (LAS float*)(PI + 64 * TST);
    const int tid = otid(), lane = tid & 63, w = tid >> 6, fr = lane & 15, fq = lane >> 4;
    const int cg4 = tid >> 5, dg = tid & 31;
    for (int it = obid(); it < 256; it += gridDim.x) {
        const int b = it >> 3, h = (it >> 1) & 3, sl = it & 1;
        const float l2g_ = log2f(1.0f - exp2f(-5.0f - (float)h));
        f32x4 St[16][2];
#pragma unroll
        for (int t = 0; t < 16; ++t) { St[t][0] = (f32x4){0.f, 0.f, 0.f, 0.f}; St[t][1] = (f32x4){0.f, 0.f, 0.f, 0.f}; }
        const bf16_t* kp = Kb + (size_t)(b * SEQ + 4 * cg4) * 1024 + 256 * h + 8 * dg;
        const bf16_t* vp = VO + (size_t)(b * SEQ + 4 * cg4) * 2048 + 512 * h + 256 * sl + 8 * dg;
        const bf16_t* qp = Qb + (size_t)(b * SEQ + (tid >> 5)) * 1024 + 256 * h + 8 * dg;
        for (int n = 0; n < 32; ++n) {
            const int t0 = b * SEQ + n * 64;
            float l2g = l2g_; asm volatile("" : "+v"(l2g));
            const float cd = exp2f(l2g * 64.0f);
            {
              u32x4 vw[4], kw[4];
#pragma unroll
              for (int r = 0; r < 4; ++r) kw[r] = *(const u32x4*)(kp + (size_t)(n * 64 + r) * 1024);
#pragma unroll
              for (int r = 0; r < 4; ++r) *(LAS u32x4*)(KI + (4 * cg4 + r) * QST + 16 * dg) = kw[r];
#pragma unroll
              for (int r = 0; r < 4; ++r) vw[r] = *(const u32x4*)(vp + (size_t)(n * 64 + r) * 2048);
              { u32x4 qw[4];
#pragma unroll
              for (int r = 0; r < 4; ++r) qw[r] = *(const u32x4*)(qp + (size_t)(n * 64 + 16 * r) * 1024);
#pragma unroll
              for (int r = 0; r < 4; ++r) *(LAS u32x4*)(QI + ((tid >> 5) + 16 * r) * QST + 16 * dg) = qw[r]; }
              float kd[4];
#pragma unroll
              for (int r = 0; r < 4; ++r) kd[r] = exp2f(l2g * (float)(63 - (4 * cg4 + r)));
#pragma unroll
              for (int dd = 0; dd < 8; ++dd) { float v[4];
#pragma unroll
                  for (int r = 0; r < 4; ++r) { const unsigned wd = dd < 2 ? kw[r].x : dd < 4 ? kw[r].y : dd < 6 ? kw[r].z : kw[r].w; v[r] = ((dd & 1) ? bfhi(wd) : bflo(wd)) * kd[r]; }
                  u32x2 o; o.x = cvt_pk_bf16(v[0], v[1]); o.y = cvt_pk_bf16(v[2], v[3]);
                  *(LAS u32x2*)(KT + (8 * dg + dd) * TST + 8 * cg4) = o; }
#pragma unroll
              for (int ee = 0; ee < 8; ++ee) { unsigned v[4];
#pragma unroll
                  for (int r = 0; r < 4; ++r) { const unsigned wd = ee < 2 ? vw[r].x : ee < 4 ? vw[r].y : ee < 6 ? vw[r].z : vw[r].w; v[r] = (ee & 1) ? (wd >> 16) : (wd & 0xffffu); }
                  u32x2 o; o.x = v[0] | (v[1] << 16); o.y = v[2] | (v[3] << 16);
                  *(LAS u32x2*)(VT + (8 * dg + ee) * TST + 8 * cg4) = o; }
            }
            __syncthreads();
            { const int mt = w >> 1;
              f32x4 s0 = (f32x4){0.f, 0.f, 0.f, 0.f}, s1 = s0;
#pragma unroll
              for (int ks = 0; ks < 8; ++ks) {
                  const bf16x8 ka = *(const LAS bf16x8*)(KI + (16 * mt + fr) * QST + (32 * ks + 8 * fq) * 2);
                  const bf16x8 q0 = *(const LAS bf16x8*)(QI + (16 * (2 * (w & 1)) + fr) * QST + (32 * ks + 8 * fq) * 2);
                  const bf16x8 q1 = *(const LAS bf16x8*)(QI + (16 * (2 * (w & 1) + 1) + fr) * QST + (32 * ks + 8 * fq) * 2);
                  s0 = __builtin_amdgcn_mfma_f32_16x16x32_bf16(ka, q0, s0, 0, 0, 0);
                  s1 = __builtin_amdgcn_mfma_f32_16x16x32_bf16(ka, q1, s1, 0, 0, 0); }
#pragma unroll
              for (int z = 0; z < 2; ++z) { const int c = 16 * (2 * (w & 1) + z) + fr; const f32x4 sv = z ? s1 : s0; float p[4];
#pragma unroll
                  for (int j = 0; j < 4; ++j) { const int m = 16 * mt + 4 * fq + j; const int dist = c > m ? c - m : m - c; p[j] = sv[j] * exp2f(l2g * (float)dist); }
                  u32x2 o; o.x = cvt_pk_bf16(p[0], p[1]); o.y = cvt_pk_bf16(p[2], p[3]);
                  *(LAS u32x2*)(PI + c * TST + (16 * mt + 4 * fq) * 2) = o; } }
            __syncthreads();
            f32x4 O[2][4];
#pragma unroll
            for (int nt = 0; nt < 2; ++nt)
#pragma unroll
                for (int mt = 0; mt < 4; ++mt) O[nt][mt] = (f32x4){0.f, 0.f, 0.f, 0.f};
#pragma unroll
            for (int ks = 0; ks < 8; ++ks) {
                bf16x8 sa[2];
#pragma unroll
                for (int nt = 0; nt < 2; ++nt) { u32x4 pb; pb.x = cvt_pk_bf16(St[2 * ks][nt][0], St[2 * ks][nt][1]); pb.y = cvt_pk_bf16(St[2 * ks][nt][2], St[2 * ks][nt][3]);
                    pb.z = cvt_pk_bf16(St[2 * ks + 1][nt][0], St[2 * ks + 1][nt][1]); pb.w = cvt_pk_bf16(St[2 * ks + 1][nt][2], St[2 * ks + 1][nt][3]); sa[nt] = __builtin_bit_cast(bf16x8, pb); }
#pragma unroll
                for (int mt = 0; mt < 4; ++mt) {
                    const u32x2 lo = *(const LAS u32x2*)(QI + (16 * mt + fr) * QST + (32 * ks + 4 * fq) * 2);
                    const u32x2 hi = *(const LAS u32x2*)(QI + (16 * mt + fr) * QST + (32 * ks + 16 + 4 * fq) * 2);
                    u32x4 pq; pq.x = lo.x; pq.y = lo.y; pq.z = hi.x; pq.w = hi.y; const bf16x8 qf = __builtin_bit_cast(bf16x8, pq);
                    O[0][mt] = __builtin_amdgcn_mfma_f32_16x16x32_bf16(sa[0], qf, O[0][mt], 0, 0, 0);
                    O[1][mt] = __builtin_amdgcn_mfma_f32_16x16x32_bf16(sa[1], qf, O[1][mt], 0, 0, 0); }
            }
#pragma unroll
            for (int mt = 0; mt < 4; ++mt) { const float qd = exp2f(l2g * (float)(16 * mt + fr + 1)); O[0][mt] *= qd; O[1][mt] *= qd; }
            bf16x8 vb[2][2];
#pragma unroll
            for (int nt = 0; nt < 2; ++nt)
#pragma unroll
                for (int ks = 0; ks < 2; ++ks) vb[nt][ks] = *(const LAS bf16x8*)(VT + (32 * w + 16 * nt + fr) * TST + (32 * ks + 8 * fq) * 2);
#pragma unroll
            for (int ks = 0; ks < 2; ++ks)
#pragma unroll
                for (int mt = 0; mt < 4; ++mt) {
                    const bf16x8 pa = *(const LAS bf16x8*)(PI + (16 * mt + fr) * TST + (32 * ks + 8 * fq) * 2);
                    O[0][mt] = __builtin_amdgcn_mfma_f32_16x16x32_bf16(vb[0][ks], pa, O[0][mt], 0, 0, 0);
                    O[1][mt] = __builtin_amdgcn_mfma_f32_16x16x32_bf16(vb[1][ks], pa, O[1][mt], 0, 0, 0); }
#pragma unroll
            for (int mt = 0; mt < 4; ++mt) { float q = 0.f;
#pragma unroll
                for (int nt = 0; nt < 2; ++nt) { const f32x4 v = O[nt][mt];
                    u32x2 o; o.x = cvt_pk_bf16(v[0], v[1]); o.y = cvt_pk_bf16(v[2], v[3]);
                    *(u32x2*)(VO + (size_t)(t0 + 16 * mt + fr) * 2048 + 512 * h + 256 * sl + 32 * w + 16 * nt + 4 * fq) = o;
                    q += (v[0] * v[0] + v[1] * v[1]) + (v[2] * v[2] + v[3] * v[3]); }
                q += __shfl_xor(q, 16); q += __shfl_xor(q, 32);
                if (fq == 0) RS[(16 * mt + fr) * 8 + w] = q; }
#pragma unroll
            for (int t = 0; t < 16; ++t) { St[t][0] *= cd; St[t][1] *= cd;
#pragma unroll
                for (int ks = 0; ks < 2; ++ks) { const bf16x8 ka = *(const LAS bf16x8*)(KT + (16 * t + fr) * TST + (32 * ks + 8 * fq) * 2);
                    St[t][0] = __builtin_amdgcn_mfma_f32_16x16x32_bf16(ka, vb[0][ks], St[t][0], 0, 0, 0);
                    St[t][1] = __builtin_amdgcn_mfma_f32_16x16x32_bf16(ka, vb[1][ks], St[t][1], 0, 0, 0); } }
            __syncthreads();
            if (tid < 64) { float q = 0.f;
#pragma unroll
                for (int k = 0; k < 8; ++k) q += RS[tid * 8 + k];
                nstat[((size_t)(t0 + tid) * 4 + h) * 2 + sl] = q; }
        }
    }
}
DI void phase_gate(bf16_t* Gb, const bf16_t* Ob, const float* nstat) {
    const size_t gt = (size_t)obid() * NTHR + otid(), GT = (size_t)gridDim.x * NTHR;
    for (size_t i0 = gt; i0 < (size_t)MTOK * 256; i0 += 4 * GT) {
        u32x4 gw[4], ow[4]; f32x2 ns[4];
#pragma unroll
        for (int u = 0; u < 4; ++u) { const size_t i = i0 + u * GT; const size_t tok = i >> 8; const int c8 = (int)(i & 255) * 8, h = c8 >> 9;
            gw[u] = *(const u32x4*)(Gb + tok * 2048 + c8); ow[u] = *(const u32x4*)(Ob + tok * 2048 + c8); ns[u] = *(const f32x2*)(nstat + (tok * 4 + h) * 2); }
#pragma unroll
        for (int u = 0; u < 4; ++u) { const size_t i = i0 + u * GT; const size_t tok = i >> 8; const int c8 = (int)(i & 255) * 8;
            const float rstd = rsqrtf((ns[u].x + ns[u].y) * (1.f / 512.f) + EPS);
            u32x4 r; r.x = cvt_pk_bf16(bflo(gw[u].x) * bflo(ow[u].x) * rstd, bfhi(gw[u].x) * bfhi(ow[u].x) * rstd); r.y = cvt_pk_bf16(bflo(gw[u].y) * bflo(ow[u].y) * rstd, bfhi(gw[u].y) * bfhi(ow[u].y) * rstd);
            r.z = cvt_pk_bf16(bflo(gw[u].z) * bflo(ow[u].z) * rstd, bfhi(gw[u].z) * bfhi(ow[u].z) * rstd); r.w = cvt_pk_bf16(bflo(gw[u].w) * bflo(ow[u].w) * rstd, bfhi(gw[u].w) * bfhi(ow[u].w) * rstd);
            *(u32x4*)(Gb + tok * 2048 + c8) = r; }
    }
}

__global__ void __launch_bounds__(NTHR, 2) fwd_megakernel(Args a) {
    extern __shared__ __attribute__((aligned(16))) unsigned char lds_raw[];
    LAS unsigned char* lds = (LAS unsigned char*)lds_raw;
    cg::grid_group grid = cg::this_grid();
    volatile LAS unsigned* MISC = (volatile LAS unsigned*)(lds + 155648);
    if (threadIdx.x < 64) MISC[threadIdx.x] = 0u;
    __syncthreads();
    XcdBarrier xbar; xbar.bar = (unsigned*)(a.ws + WS_BAR); xbar.x = 0; xbar.st = MISC;
    for (int ph = a.ph_lo; ph < a.ph_hi; ++ph) {
        unsigned char* ws = a.ws;
        const int G = gridDim.x;
        float* mod = (float*)(ws + WS_MOD);
        bf16_t* H = (bf16_t*)(ws + WS_H);
        bf16_t* T0 = (bf16_t*)(ws + WS_T0); bf16_t* T1 = (bf16_t*)(ws + WS_T1); bf16_t* T2 = (bf16_t*)(ws + WS_T2);
        float* xo = a.out;
        float* rss = (float*)(ws + WS_RSS);
        const float* gsb = (const float*)(ws + WS_GS);
        LAS float* rsd = (LAS float*)(lds + pg8::RSD_OFF);
        pg8::StaticOrder S;
        if (ph == 0) { phase_prep(a, lds); }
        else if (ph == 1) {
            const int c = obid();
            if (c < 148) {
                int l, which = 0, N, loc; const bf16_t* Bt; float* cbo;
                if (c < 16) { l = 0; loc = c; N = 4096; Bt = (const bf16_t*)(ws + WS_W_SG_IN); cbo = (float*)(ws + WS_CBM); }
                else if (c < 20) { l = 1; loc = c - 16; N = 1024; Bt = (const bf16_t*)(ws + WS_W_POOL_IN); cbo = (float*)(ws + WS_CBM) + 131072; }
                else if (c < 44) { l = 2; loc = c - 20; N = RETIN; Bt = (const bf16_t*)(ws + WS_W_RET_IN); cbo = (float*)(ws + WS_CBM) + 163840; }
                else if (c < 60) { l = 3; loc = c - 44; N = 4096; Bt = (const bf16_t*)(ws + WS_W_SG_IN) + (size_t)4096 * D; cbo = (float*)(ws + WS_CBM) + 360448; }
                else { l = (c - 60) / 22; loc = (c - 60) % 22; N = 2 * DFF; which = 1; Bt = (const bf16_t*)(ws + WS_W_FFN_IN) + (size_t)l * 2 * DFF * D; cbo = (float*)(ws + WS_CBF) + (size_t)l * 32 * 2 * DFF; }
                pg8::Gemm g{(const bf16_t*)(ws + WS_SHB) + (size_t)(32 * (2 * l + which)) * 1024, Bt, D, D, D, 0};
                S.init(256, N, N / 256, loc); pg8::EpiCB E{cbo, N}; pg8::gemm_phase(lds, g, S, E);
            }
            phase_xg0(a.in[0], gsb, H, rss);
        }
        else if (ph == 24) { phase_final_norm(H, a.in[20], xo); }
        else {
            const int l = ph >= 19 ? 3 : ph >= 13 ? 2 : ph >= 7 ? 1 : 0;
            const int base = l == 3 ? 19 : l == 2 ? 13 : l == 1 ? 7 : 2;
            const int kind = l % 3, j = l / 3, nmix = kind == 0 ? 2 : 3;
            const int s = ph - base;
            const float* modl = mod + (size_t)l * 32 * 6144;
            if (s < nmix) {
                if (kind == 0) {
                    float* stat = (float*)T2;
                    if (s == 0) { pg8::Gemm g{H, (const bf16_t*)(ws + WS_W_SG_IN) + (size_t)j * 4096 * D, D, D, D, 0}; S.init(MTOK, 4096, G, obid()); pg8::prep_rstd(lds, S, rss);
                        pg8::EpiGeluUV E{T0, T1, stat, (const float*)(ws + WS_CBM) + (l == 0 ? 0 : 360448), rsd, lds}; pg8::gemm_phase(lds, g, S, E); }
                    else { phase_sg(lds, T0, T1, stat, a.in[9] + j * SGW, (const bf16_t*)(ws + WS_W_SG_S) + (size_t)j * 8 * 16384, a.in[11] + j * 8 * 128, T0); }
                } else if (kind == 1) {
                    if (s == 0) { pg8::Gemm g{H, (const bf16_t*)(ws + WS_W_POOL_IN), D, D, D, 0}; S.init(MTOK, D, G, obid()); pg8::prep_rstd(lds, S, rss);
                        pg8::EpiBf16 E{T0, D, nullptr, nullptr, (const float*)(ws + WS_CBM) + 131072, rsd, lds}; pg8::gemm_phase(lds, g, S, E); }
                    else if (s == 1) { phase_pool(T0, T1); }
                    else { pg8::Gemm g{T1, (const bf16_t*)(ws + WS_W_POOL_GRP), D, 256, 256, 256}; S.init(MTOK, D, G, obid());
                        pg8::EpiBf16 E{T2, D, a.in[15], a.in[16], nullptr, rsd, lds}; pg8::gemm_phase(lds, g, S, E); }
                } else {
                    bf16_t* Qb = T0; bf16_t* Kb = T0 + (size_t)MTOK * 1024; float* nstat = xo;
                    if (s == 0) { pg8::Gemm g{H, (const bf16_t*)(ws + WS_W_RET_IN), D, D, D, 0}; S.init(MTOK, 4096, G, obid()); pg8::prep_rstd(lds, S, rss);
                        pg8::EpiRet E{Qb, Kb, T1, T2, (const float*)(ws + WS_ROPE), (const float*)(ws + WS_ROPE) + SEQ * 128, (const float*)(ws + WS_CBM) + 163840, rsd, lds}; pg8::gemm_phase(lds, g, S, E); }
                    else if (s == 1) { phase_ret(lds, Qb, Kb, T1, nstat); }
                    else { pg8::Gemm g{H, (const bf16_t*)(ws + WS_W_RET_IN) + (size_t)4096 * D, D, D, D, 0}; S.init(MTOK, 2048, G, obid()); pg8::prep_rstd(lds, S, rss);
                        pg8::EpiGate E{T2, T1, nstat, (const float*)(ws + WS_CBM) + 163840, rsd, lds}; pg8::gemm_phase(lds, g, S, E); }
                }
            }
            else if (s == nmix || s == nmix + 2) {
                pg8::Gemm g2; const float* gate; const float* gsn; const float* gsc;
                if (s == nmix + 2) { g2 = pg8::Gemm{T0, (const bf16_t*)(ws + WS_W_FFN_OUT) + (size_t)l * D * DFF, DFF, DFF, DFF, 0}; gate = modl + 5120; gsc = gsb + (size_t)(2 * l + 1) * 32 * 1024; gsn = l < 3 ? gsb + (size_t)(2 * l + 2) * 32 * 1024 : nullptr; }
                else { gate = modl + 2048; gsc = gsb + (size_t)(2 * l) * 32 * 1024; gsn = gsb + (size_t)(2 * l + 1) * 32 * 1024;
                    if (kind == 0) g2 = pg8::Gemm{T0, (const bf16_t*)(ws + WS_W_SG_OUT) + (size_t)j * D * SGW, SGW, SGW, SGW, 0};
                    else if (kind == 1) g2 = pg8::Gemm{T2, (const bf16_t*)(ws + WS_W_POOL_OUT), D, D, D, 0};
                    else g2 = pg8::Gemm{T2, (const bf16_t*)(ws + WS_W_RET_OUT), 2048, 2048, 2048, 0}; }
                S.init(MTOK, D, G, obid()); pg8::EpiResid E{H, gate, gsn, gsc, rss, lds}; pg8::gemm_phase(lds, g2, S, E);
            }
            else { pg8::Gemm g{H, (const bf16_t*)(ws + WS_W_FFN_IN) + (size_t)l * 2 * DFF * D, D, D, D, 0}; S.init(MTOK, 2 * DFF, G, obid()); pg8::prep_rstd(lds, S, rss);
                pg8::EpiSwiglu E{T0, (const float*)(ws + WS_CBF) + (size_t)l * 32 * 2 * DFF, rsd, lds}; pg8::gemm_phase(lds, g, S, E); }
        }
        if (ph + 1 < a.ph_hi) {
            if (ph == a.ph_lo) { grid.sync(); xbar = xcd_barrier_post((unsigned*)(a.ws + WS_BAR), MISC); }
            else xcd_barrier(xbar);
        }
    }
}

#ifndef MK_PER_PHASE
#define MK_PER_PHASE 0
#endif
constexpr int N_PHASES = 2 + (5 + 6 + 6 + 5) + 1;

extern "C" void kernel_launch(void* const* d_in, const int* in_sizes, int n_in, void* d_out, int out_size, void* d_ws, size_t ws_size, hipStream_t stream) {
    static int grid = 0;
    if (grid == 0) {
        if (n_in != 21 || ws_size < WS_END) { fprintf(stderr, "kernel_launch: unexpected n_in %d / ws_size %zu\n", n_in, ws_size); grid = -1; return; }
        int dev = 0, cus = 0, per_cu = 0;
        hipGetDevice(&dev);
        hipDeviceGetAttribute(&cus, hipDeviceAttributeMultiprocessorCount, dev);
        if (hipFuncSetAttribute((const void*)fwd_megakernel, hipFuncAttributeMaxDynamicSharedMemorySize, LDS_BYTES) != hipSuccess) { fprintf(stderr, "kernel_launch: hipFuncSetAttribute failed\n"); grid = -1; return; }
        if (hipOccupancyMaxActiveBlocksPerMultiprocessor(&per_cu, (const void*)fwd_megakernel, NTHR, LDS_BYTES) != hipSuccess || per_cu < 1) { fprintf(stderr, "kernel_launch: occupancy query says %d\n", per_cu); per_cu = 1; }
        (void)hipGetLastError();
        grid = cus;
        if (grid != 256) fprintf(stderr, "kernel_launch: %d CUs\n", grid);
    }
    if (grid < 0) return;
    Args a{};
    for (int i = 0; i < 21; ++i) a.in[i] = (const float*)d_in[i];
    a.out = (float*)d_out; a.ws = (unsigned char*)d_ws;
#if MK_PER_PHASE
    for (int p = 0; p < N_PHASES; ++p) { a.ph_lo = p; a.ph_hi = p + 1; hipLaunchKernelGGL(fwd_megakernel, dim3(grid), dim3(NTHR), LDS_BYTES, stream, a); }
#else
    a.ph_lo = 0; a.ph_hi = N_PHASES;
    void* args[] = {&a};
    hipError_t e = hipLaunchCooperativeKernel((const void*)fwd_megakernel, dim3(grid), dim3(NTHR), args, LDS_BYTES, stream);
    if (e != hipSuccess) fprintf(stderr, "kernel_launch: cooperative launch failed: %s\n", hipGetErrorString(e));
#endif
}
```
